# Optimizing an MI355X kernel written in HIP

```python
import jax, jax.numpy as jnp
from jax import lax
import numpy as np

D_MODEL = 1024
BATCH = 8
SEQ = 8192
DEPTH = 1

CHUNK = 64
RET_HEADS = 4
RET_DK = 128
RET_DV = 256
GLA_HEADS = 4
GLA_DK = 128
GLA_DV = 256
GLA_GATE_RANK = 16
GLA_GATE_TAU = 16.0
D_FF = 2816
ROPE_BASE = 10000.0
NORM_EPS = 1e-6
RET_QK = RET_HEADS * RET_DK
RET_V = RET_HEADS * RET_DV
GLA_QK = GLA_HEADS * GLA_DK
GLA_V = GLA_HEADS * GLA_DV
IN_SPLITS = (RET_QK, RET_QK, RET_V, RET_V, GLA_QK, GLA_QK, GLA_V, GLA_V, GLA_GATE_RANK, D_MODEL, D_MODEL)
D_IN = RET_QK * 2 + RET_V * 2 + GLA_QK * 2 + GLA_V * 2 + GLA_GATE_RANK + 2 * D_MODEL

kernel_name = "hybrid_retention_gla_macaron_block"


def _rmsnorm(x, w):
    xf = x.astype(jnp.float32)
    y = xf * lax.rsqrt(jnp.mean(xf * xf, axis=-1, keepdims=True) + NORM_EPS)
    return (y * w.astype(jnp.float32)).astype(x.dtype)


def _swiglu(x, w1, w3, w2):
    return (jax.nn.silu(x @ w1) * (x @ w3)) @ w2


def _split_columns(p):
    outs = []
    off = 0
    for width in IN_SPLITS:
        outs.append(p[..., off:off + width])
        off += width
    return outs


def _rotary(x, pos):
    half = x.shape[-1] // 2
    inv_freq = ROPE_BASE ** (-jnp.arange(half, dtype=jnp.float32) / half)
    ang = pos.astype(jnp.float32)[:, None] * inv_freq[None, :]
    cos = jnp.cos(ang)[:, None, :]
    sin = jnp.sin(ang)[:, None, :]
    x = x.astype(jnp.float32)
    x1, x2 = x[..., :half], x[..., half:]
    return jnp.concatenate([x1 * cos - x2 * sin, x2 * cos + x1 * sin], axis=-1)


def _to_chunks(t):
    b, s, h, d = t.shape
    return t.reshape(b, s // CHUNK, CHUNK, h, d).transpose(1, 0, 3, 2, 4)


def _from_chunks(t):
    n, b, h, c, d = t.shape
    return t.transpose(1, 0, 3, 2, 4).reshape(b, n * c, h, d)


def _retention_chunkwise(q, k, v):
    heads = jnp.arange(RET_HEADS, dtype=jnp.float32)
    log_gamma = jnp.log1p(-jnp.exp2(-5.0 - heads))
    idx = jnp.arange(CHUNK, dtype=jnp.float32)
    intra = jnp.exp(log_gamma[:, None, None] * jnp.abs(idx[:, None] - idx[None, :]))
    q_decay = jnp.exp(log_gamma[:, None] * (idx[None, :] + 1.0))[:, :, None]
    k_decay = jnp.exp(log_gamma[:, None] * (CHUNK - 1.0 - idx[None, :]))[:, :, None]
    chunk_decay = jnp.exp(log_gamma * CHUNK)[:, None, None]

    def step(state, inp):
        qc, kc, vc = inp
        scores = jnp.einsum('bhnd,bhmd->bhnm', qc, kc) * intra
        out = (jnp.einsum('bhnm,bhmv->bhnv', scores, vc)
               + jnp.einsum('bhnd,bhdv->bhnv', qc * q_decay, state))
        state = chunk_decay * state + jnp.einsum('bhmd,bhmv->bhdv', kc * k_decay, vc)
        return state, out

    b = q.shape[1]
    state0 = jnp.zeros((b, RET_HEADS, RET_DK, RET_DV), jnp.float32)
    _, out = lax.scan(step, state0, (q, k, v))
    return out


def _gla_chunkwise(q, k, v, log_alpha):
    def step(state, inp):
        qc, kc, vc, la = inp
        cum = jnp.cumsum(la, axis=-2)
        last = cum[..., -1:, :]
        pair = jnp.exp(-jnp.abs(cum[..., :, None, :] - cum[..., None, :, :]))
        scores = jnp.einsum('bhnmd,bhmd->bhnm', qc[..., :, None, :] * pair, kc)
        out = (jnp.einsum('bhnm,bhmv->bhnv', scores, vc)
               + jnp.einsum('bhnd,bhdv->bhnv', qc * jnp.exp(cum), state))
        state = (jnp.swapaxes(jnp.exp(last), -1, -2) * state
                 + jnp.einsum('bhmd,bhmv->bhdv', kc * jnp.exp(last - cum), vc))
        return state, out

    b = q.shape[1]
    state0 = jnp.zeros((b, GLA_HEADS, GLA_DK, GLA_DV), jnp.float32)
    _, out = lax.scan(step, state0, (q, k, v, log_alpha))
    return out


def setup_inputs(seed: int = 0) -> dict:
    key = jax.random.key(seed)
    ks = jax.random.split(key, 20)
    f32 = jnp.float32

    def nrm(k, shape, fan_in):
        return jax.random.normal(k, shape, f32) * (fan_in ** -0.5)

    def gain(k, shape):
        return 1.0 + 0.02 * jax.random.normal(k, shape, f32)

    return {
        "x": jax.random.normal(ks[0], (BATCH, SEQ, D_MODEL), f32),
        "norm_ffn1": gain(ks[1], (DEPTH, D_MODEL)),
        "ffn1_w1": nrm(ks[2], (DEPTH, D_MODEL, D_FF), D_MODEL),
        "ffn1_w3": nrm(ks[3], (DEPTH, D_MODEL, D_FF), D_MODEL),
        "ffn1_w2": nrm(ks[4], (DEPTH, D_FF, D_MODEL), D_FF),
        "norm_mix": gain(ks[5], (DEPTH, D_MODEL)),
        "w_in": nrm(ks[6], (DEPTH, D_MODEL, D_IN), D_MODEL),
        "gla_gate_w2": nrm(ks[7], (DEPTH, GLA_GATE_RANK, GLA_QK), GLA_GATE_RANK),
        "gla_gate_b": 0.1 * jax.random.normal(ks[8], (DEPTH, GLA_QK), f32),
        "gla_norm_w": gain(ks[9], (DEPTH, GLA_DV)),
        "w_branch_ret": nrm(ks[10], (DEPTH, RET_V, D_MODEL), RET_V),
        "w_branch_gla": nrm(ks[11], (DEPTH, GLA_V, D_MODEL), GLA_V),
        "w_out": nrm(ks[12], (DEPTH, D_MODEL, D_MODEL), D_MODEL),
        "norm_ffn2": gain(ks[13], (DEPTH, D_MODEL)),
        "ffn2_w1": nrm(ks[14], (DEPTH, D_MODEL, D_FF), D_MODEL),
        "ffn2_w3": nrm(ks[15], (DEPTH, D_MODEL, D_FF), D_MODEL),
        "ffn2_w2": nrm(ks[16], (DEPTH, D_FF, D_MODEL), D_FF),
        "norm_final": gain(ks[17], (D_MODEL,)),
    }


def reference(x, norm_ffn1, ffn1_w1, ffn1_w3, ffn1_w2, norm_mix, w_in, gla_gate_w2, gla_gate_b,
              gla_norm_w, w_branch_ret, w_branch_gla, w_out, norm_ffn2, ffn2_w1, ffn2_w3, ffn2_w2,
              norm_final):
    b, s, _ = x.shape
    pos = jnp.arange(s, dtype=jnp.int32)
    h = x
    for l in range(DEPTH):
        h = h + 0.5 * _swiglu(_rmsnorm(h, norm_ffn1[l]), ffn1_w1[l], ffn1_w3[l], ffn1_w2[l])

        u = _rmsnorm(h, norm_mix[l])
        qa, ka, va, ra, qb, kb, vb, rb, lr, ga, gb = _split_columns(u @ w_in[l])

        qa = _rotary(qa.reshape(b, s, RET_HEADS, RET_DK), pos) * (RET_DK ** -0.5)
        ka = _rotary(ka.reshape(b, s, RET_HEADS, RET_DK), pos)
        va = va.reshape(b, s, RET_HEADS, RET_DV).astype(jnp.float32)
        oa = _from_chunks(_retention_chunkwise(_to_chunks(qa), _to_chunks(ka), _to_chunks(va)))
        mu = jnp.mean(oa, axis=-1, keepdims=True)
        var = jnp.mean(jnp.square(oa - mu), axis=-1, keepdims=True)
        oa = ((oa - mu) * lax.rsqrt(var + NORM_EPS)).reshape(b, s, RET_V)
        oa = (jax.nn.silu(ra.astype(jnp.float32)) * oa).astype(h.dtype)
        y_ret = oa @ w_branch_ret[l]

        log_alpha = jax.nn.log_sigmoid((lr @ gla_gate_w2[l] + gla_gate_b[l]).astype(jnp.float32)) / GLA_GATE_TAU
        log_alpha = log_alpha.reshape(b, s, GLA_HEADS, GLA_DK)
        qb = qb.reshape(b, s, GLA_HEADS, GLA_DK).astype(jnp.float32) * (GLA_DK ** -0.5)
        kb = kb.reshape(b, s, GLA_HEADS, GLA_DK).astype(jnp.float32)
        vb = vb.reshape(b, s, GLA_HEADS, GLA_DV).astype(jnp.float32)
        ob = _from_chunks(_gla_chunkwise(_to_chunks(qb), _to_chunks(kb), _to_chunks(vb), _to_chunks(log_alpha)))
        ob = ob * lax.rsqrt(jnp.mean(ob * ob, axis=-1, keepdims=True) + NORM_EPS) * gla_norm_w[l].astype(jnp.float32)
        ob = (jax.nn.silu(rb.astype(jnp.float32)) * ob.reshape(b, s, GLA_V)).astype(h.dtype)
        y_gla = ob @ w_branch_gla[l]

        merged = jax.nn.sigmoid(ga) * y_ret + jax.nn.sigmoid(gb) * y_gla
        h = h + merged @ w_out[l]

        h = h + 0.5 * _swiglu(_rmsnorm(h, norm_ffn2[l]), ffn2_w1[l], ffn2_w3[l], ffn2_w2[l])
    return _rmsnorm(h, norm_final)
```

```cpp
#include <hip/hip_runtime.h>
#include <hip/hip_cooperative_groups.h>
#include <cstdio>
namespace cg = cooperative_groups;

#define LAS __attribute__((address_space(3)))
#define DI __device__ __forceinline__
typedef unsigned short bf16_t;
typedef short bf16x8 __attribute__((ext_vector_type(8)));
typedef float f32x4 __attribute__((ext_vector_type(4)));
typedef float f32x2 __attribute__((ext_vector_type(2)));
typedef unsigned u32x4 __attribute__((ext_vector_type(4)));
typedef unsigned u32x2 __attribute__((ext_vector_type(2)));
typedef __bf16 bf16v2 __attribute__((ext_vector_type(2)));

constexpr int NTOK = 65536, DM = 1024, DFF = 2816, SEQ = 8192, DIN = 8208;
constexpr int LDS_BYTES = 131072 + 16;

constexpr size_t SZ_W13 = (size_t)5632 * 1024 * 2, SZ_W2T = (size_t)1024 * 2816 * 2, SZ_1K = (size_t)1024 * 1024 * 2;
constexpr size_t WS_W13_1 = 0;
constexpr size_t WS_W2T_1 = WS_W13_1 + SZ_W13;
constexpr size_t WS_W13_2 = WS_W2T_1 + SZ_W2T;
constexpr size_t WS_W2T_2 = WS_W13_2 + SZ_W13;
constexpr size_t WS_WQK = WS_W2T_2 + SZ_W2T;
constexpr size_t WS_WV = WS_WQK + 2 * SZ_1K;
constexpr size_t WS_WRG = WS_WV + 2 * SZ_1K;
constexpr size_t WS_WBR = WS_WRG + 4 * SZ_1K;
constexpr size_t WS_WBG = WS_WBR + SZ_1K;
constexpr size_t WS_WOUT = WS_WBG + SZ_1K;
constexpr size_t WS_WLR = WS_WOUT + SZ_1K;
constexpr size_t WS_ROTC = WS_WLR + 32768;
constexpr size_t WS_ROTS = WS_ROTC + (size_t)8192 * 64 * 4;
constexpr size_t WS_XN = WS_ROTS + (size_t)8192 * 64 * 4;
constexpr size_t SZ_ACT = (size_t)NTOK * 1024 * 2;
constexpr size_t WS_BIG = WS_XN + SZ_ACT;
constexpr size_t WS_G = WS_BIG;
constexpr size_t WS_QKOA = WS_BIG;
constexpr size_t WS_QKOB = WS_QKOA + SZ_ACT;
constexpr size_t WS_VTA = WS_QKOB + SZ_ACT;
constexpr size_t WS_VTB = WS_VTA + SZ_ACT;
constexpr size_t WS_GAB = WS_VTA;
constexpr size_t WS_CUM = WS_VTB + SZ_ACT;
constexpr size_t WS_MRG = WS_CUM;
constexpr size_t WS_BAR = WS_CUM + (size_t)NTOK * 512 * 4;
constexpr size_t WS_STATE = WS_BAR + 16384;
constexpr size_t WS_DSEG = WS_STATE + (size_t)64 * 3 * 32768 * 4;
constexpr size_t WS_SS1 = WS_DSEG + 64 * 3 * 128 * 4;
constexpr size_t WS_SS2 = WS_SS1 + (size_t)NTOK * 4;
constexpr size_t WS_END = WS_SS2 + (size_t)NTOK * 4;

struct Args {
    const float* in[18];
    float* out;
    unsigned char* ws;
};

DI unsigned pk_bf16(float lo, float hi) { f32x2 v = {lo, hi}; return __builtin_bit_cast(unsigned, __builtin_convertvector(v, bf16v2)); }
DI float bf_lo(unsigned w) { return __uint_as_float(w << 16); }
DI float bf_hi(unsigned w) { return __uint_as_float(w & 0xffff0000u); }
DI int opaque_tid() { int t = threadIdx.x; asm volatile("" : "+v"(t)); return t; }
DI float rowscale(const float* ss, int row) { return rsqrtf(ss[row] * (1.0f / 1024.0f) + 1e-6f); }
struct RowScales { float r[2][4]; };
DI RowScales load_rowscales(const float* ss, int row0) {
    RowScales t;
#pragma unroll
    for (int ai = 0; ai < 2; ++ai)
#pragma unroll
        for (int m = 0; m < 4; ++m) t.r[ai][m] = ss[row0 + ai * 128 + m * 16];
#pragma unroll
    for (int ai = 0; ai < 2; ++ai)
#pragma unroll
        for (int m = 0; m < 4; ++m) t.r[ai][m] = rsqrtf(t.r[ai][m] * (1.0f / 1024.0f) + 1e-6f);
    return t;
}
DI float h_get(u32x4 w, int j) { return (float)__builtin_bit_cast(_Float16, (unsigned short)(w[j >> 1] >> (16 * (j & 1)))); }
DI f32x4 bf_lo4(u32x4 w) { f32x4 r; r[0] = bf_lo(w.x); r[1] = bf_hi(w.x); r[2] = bf_lo(w.y); r[3] = bf_hi(w.y); return r; }
DI f32x4 bf_hi4(u32x4 w) { f32x4 r; r[0] = bf_lo(w.z); r[1] = bf_hi(w.z); r[2] = bf_lo(w.w); r[3] = bf_hi(w.w); return r; }
DI float fast_sigmoid(float x) { return __builtin_amdgcn_rcpf(1.0f + __expf(-x)); }
DI float fast_silu(float x) { return x * fast_sigmoid(x); }

namespace pg8 {
constexpr int BM = 256, BK = 64, HALF = 128, HTB = HALF * BK * 2, STAGE_BYTES = 8 * HTB, NXCD = 8, WGM = 8;
DI int lds_byte(int r, int c) { const int st = (r >> 4) * 2 + (c >> 5), rr = r & 15, cc = c & 31, ob = rr * 64 + cc * 2; return st * 1024 + (ob ^ (((ob >> 9) & 1) << 5)); }
DI void stage_rc(int b, int& R, int& C) { const int st = b / 1024, sb = b % 1024, swz = sb ^ (((sb >> 9) & 1) << 5); R = (st >> 1) * 16 + swz / 64; C = (st & 1) * 32 + (swz % 64) / 2; }
DI int perm32(int rho) { const int n = rho >> 4, i = rho & 15; return 8 * (i >> 2) + 4 * n + (i & 3); }
struct Unit { int pm, pn; };
struct Gemm { const bf16_t* A; const bf16_t* Bt; int M, N, K; };
struct StaticOrder {
    int nM, nN, nwg, G, c;
    DI void init(int M, int N, int G_, int c_) { nM = M / BM; nN = N / BM; nwg = nM * nN; G = G_; c = c_; }
    DI bool next(int i, Unit& u) const {
        const long L = (long)i * G + c; if (L >= nwg) return false;
        int wgid = (int)L; { const int q = nwg / NXCD, r = nwg % NXCD, xcd = wgid % NXCD, off = wgid / NXCD; wgid = (xcd < r ? xcd * (q + 1) : r * (q + 1) + (xcd - r) * q) + off; }
        const int nig = WGM * nN, gid = wgid / nig, fm = gid * WGM, gsz = (nM - fm) < WGM ? (nM - fm) : WGM;
        u.pm = fm + ((wgid % nig) % gsz); u.pn = (wgid % nig) / gsz; return true;
    }
};

template <class Epi>
DI void gemm_phase(LAS unsigned char* lds, const Gemm g, const StaticOrder S, const Epi E) {
    const int tid = opaque_tid(), wid = __builtin_amdgcn_readfirstlane(tid >> 6), lane = tid & 63, wr = wid >> 2, wc = wid & 3, fr = lane & 15, fq = lane >> 4;
    const int K = g.K, nt = K / BK;
    unsigned voffA[2], voffB[2];
#pragma unroll
    for (int i = 0; i < 2; ++i) { int R, C; stage_rc(tid * 16 + i * 8192, R, C); const int Rb = (R & ~31) + perm32(R & 31);
        voffA[i] = (unsigned)(R * K + C) * 2u; voffB[i] = (unsigned)(Rb * K + C) * 2u; }
    const size_t kstep = (size_t)(BK * 2);
    const size_t hstep = (size_t)HALF * K * 2;
    const size_t tstep = 2 * hstep;
    const unsigned ldsw = (unsigned)wid * 1024u;
    const int aoff = lds_byte(wr * 64 + fr, fq * 8), boff = lds_byte(wc * 32 + fr, fq * 8);
#define PG8_SA(b, h) (((b) * 2 + (h)) * HTB)
#define PG8_SB(b, h) ((4 + (b) * 2 + (h)) * HTB)
#define PG8_STAGE(bufoff, gbase, voff) do { _Pragma("unroll") for (int _i = 0; _i < 2; ++_i) \
        __builtin_amdgcn_global_load_lds((const unsigned*)((const char*)(gbase) + (voff)[_i]), (LAS unsigned*)(lds + (bufoff) + ldsw + _i * 8192), 16, 0, 0); } while (0)
#define PG8_LDA(dst, b, h) do { _Pragma("unroll") for (int m = 0; m < 4; ++m) _Pragma("unroll") for (int k = 0; k < 2; ++k) dst[m][k] = *(const LAS bf16x8*)(lds + PG8_SA(b, h) + aoff + m * 2048 + k * 1024); } while (0)
#define PG8_LDB(dst, b, h) do { _Pragma("unroll") for (int n = 0; n < 2; ++n) _Pragma("unroll") for (int k = 0; k < 2; ++k) dst[n][k] = *(const LAS bf16x8*)(lds + PG8_SB(b, h) + boff + n * 2048 + k * 1024); } while (0)
#define PG8_MMA(ai, bj, At, Bt) do { __builtin_amdgcn_s_setprio(1); _Pragma("unroll") for (int m = 0; m < 4; ++m) _Pragma("unroll") for (int n = 0; n < 2; ++n) _Pragma("unroll") for (int k = 0; k < 2; ++k) \
        acc[ai][bj][m][n] = __builtin_amdgcn_mfma_f32_16x16x32_bf16(Bt[n][k], At[m][k], acc[ai][bj][m][n], 0, 0, 0); __builtin_amdgcn_s_setprio(0); } while (0)
#define PG8_WAIT_V(n) asm volatile("s_waitcnt vmcnt(" #n ")" ::: "memory")
#define PG8_WAIT_L(n) asm volatile("s_waitcnt lgkmcnt(" #n ")" ::: "memory")
#define PG8_BAR __builtin_amdgcn_s_barrier()
#define PG8_SCHED __builtin_amdgcn_sched_barrier(0)
    Unit cur, nxt; int ui = 0;
    if (!S.next(0, cur)) return;
    f32x4 acc[2][2][4][2];
#pragma unroll
    for (int a = 0; a < 2; ++a)
#pragma unroll
        for (int b = 0; b < 2; ++b)
#pragma unroll
            for (int m = 0; m < 4; ++m)
#pragma unroll
                for (int n = 0; n < 2; ++n) acc[a][b][m][n] = (f32x4){0.f, 0.f, 0.f, 0.f};
    bf16x8 At[4][2], B0[2][2], B1[2][2];
    const char* cA = (const char*)g.A + (size_t)cur.pm * tstep; const char* cB = (const char*)g.Bt + (size_t)cur.pn * tstep;
    PG8_STAGE(PG8_SB(0, 0), cB, voffB); PG8_STAGE(PG8_SA(0, 0), cA, voffA); PG8_STAGE(PG8_SB(0, 1), cB + hstep, voffB); PG8_STAGE(PG8_SA(0, 1), cA + hstep, voffA);
    if (wr == 1) PG8_BAR;
    PG8_WAIT_V(4); PG8_BAR;
    PG8_STAGE(PG8_SB(1, 0), cB + kstep, voffB); PG8_STAGE(PG8_SA(1, 0), cA + kstep, voffA); PG8_STAGE(PG8_SB(1, 1), cB + hstep + kstep, voffB);
    PG8_WAIT_V(6); PG8_BAR;
    for (;;) {
        const bool has_next = S.next(ui + 1, nxt);
        const char* nA = has_next ? (const char*)g.A + (size_t)nxt.pm * tstep : cA; const char* nB = has_next ? (const char*)g.Bt + (size_t)nxt.pn * tstep : cB;
        for (int t = 0; t < nt; t += 2) {
            const bool last = (t == nt - 2);
            const char* a1 = cA + (size_t)(t + 1) * kstep;
            const char* a2 = last ? nA : cA + (size_t)(t + 2) * kstep; const char* b2 = last ? nB : cB + (size_t)(t + 2) * kstep;
            const char* a3 = a2 + kstep; const char* b3 = b2 + kstep;
            PG8_LDB(B0, 0, 0); PG8_SCHED; PG8_LDA(At, 0, 0); PG8_STAGE(PG8_SA(1, 1), a1 + hstep, voffA);
            PG8_WAIT_L(8); PG8_BAR; PG8_WAIT_L(0); PG8_MMA(0, 0, At, B0); PG8_BAR; PG8_SCHED;
            PG8_LDB(B1, 0, 1); PG8_STAGE(PG8_SB(0, 0), b2, voffB);
            PG8_BAR; PG8_WAIT_L(0); PG8_MMA(0, 1, At, B1); PG8_BAR;
            PG8_LDA(At, 0, 1); PG8_STAGE(PG8_SA(0, 0), a2, voffA);
            PG8_BAR; PG8_WAIT_L(0); PG8_MMA(1, 0, At, B0); PG8_BAR; PG8_SCHED;
            PG8_STAGE(PG8_SB(0, 1), b2 + hstep, voffB);
            PG8_WAIT_V(6); PG8_BAR; PG8_MMA(1, 1, At, B1); PG8_BAR;
            PG8_LDB(B0, 1, 0); PG8_SCHED; PG8_LDA(At, 1, 0); PG8_STAGE(PG8_SA(0, 1), a2 + hstep, voffA);
            PG8_WAIT_L(8); PG8_BAR; PG8_WAIT_L(0); PG8_MMA(0, 0, At, B0); PG8_BAR; PG8_SCHED;
            PG8_LDB(B1, 1, 1); PG8_STAGE(PG8_SB(1, 0), b3, voffB);
            PG8_BAR; PG8_WAIT_L(0); PG8_MMA(0, 1, At, B1); PG8_BAR;
            PG8_LDA(At, 1, 1); PG8_STAGE(PG8_SA(1, 0), a3, voffA);
            PG8_BAR; PG8_WAIT_L(0); PG8_MMA(1, 0, At, B0); PG8_BAR; PG8_SCHED;
            PG8_STAGE(PG8_SB(1, 1), b3 + hstep, voffB);
            PG8_WAIT_V(6); PG8_BAR; PG8_MMA(1, 1, At, B1); PG8_BAR;
        }
        E(acc, cur, wr, wc, fr, fq);
        if (!has_next) break;
#pragma unroll
        for (int a = 0; a < 2; ++a)
#pragma unroll
            for (int b = 0; b < 2; ++b)
#pragma unroll
                for (int m = 0; m < 4; ++m)
#pragma unroll
                    for (int n = 0; n < 2; ++n) acc[a][b][m][n] = (f32x4){0.f, 0.f, 0.f, 0.f};
        cur = nxt; cA = nA; cB = nB; ++ui;
    }
    PG8_WAIT_V(0);
    if (wr == 0) PG8_BAR;
    PG8_BAR;
#undef PG8_SA
#undef PG8_SB
#undef PG8_STAGE
#undef PG8_LDA
#undef PG8_LDB
#undef PG8_MMA
#undef PG8_WAIT_V
#undef PG8_WAIT_L
#undef PG8_BAR
#undef PG8_SCHED
}
template <class Epi0, class Epi1>
DI void gemm_phase_dual(LAS unsigned char* lds, const Gemm g, const Gemm g1, const StaticOrder S, const Epi0 E0, const Epi1 E1) {
    const int tid = opaque_tid(), wid = __builtin_amdgcn_readfirstlane(tid >> 6), lane = tid & 63, wr = wid >> 2, wc = wid & 3, fr = lane & 15, fq = lane >> 4;
    const int K = g.K, nt = K / BK;
    unsigned voffA[2], voffB[2];
#pragma unroll
    for (int i = 0; i < 2; ++i) { int R, C; stage_rc(tid * 16 + i * 8192, R, C); const int Rb = (R & ~31) + perm32(R & 31);
        voffA[i] = (unsigned)(R * K + C) * 2u; voffB[i] = (unsigned)(Rb * K + C) * 2u; }
    const size_t kstep = (size_t)(BK * 2);
    const size_t hstep = (size_t)HALF * K * 2;
    const size_t tstep = 2 * hstep;
    const unsigned ldsw = (unsigned)wid * 1024u;
    const int aoff = lds_byte(wr * 64 + fr, fq * 8), boff = lds_byte(wc * 32 + fr, fq * 8);
#define PG8_SA(b, h) (((b) * 2 + (h)) * HTB)
#define PG8_SB(b, h) ((4 + (b) * 2 + (h)) * HTB)
#define PG8_STAGE(bufoff, gbase, voff) do { _Pragma("unroll") for (int _i = 0; _i < 2; ++_i) \
        __builtin_amdgcn_global_load_lds((const unsigned*)((const char*)(gbase) + (voff)[_i]), (LAS unsigned*)(lds + (bufoff) + ldsw + _i * 8192), 16, 0, 0); } while (0)
#define PG8_LDA(dst, b, h) do { _Pragma("unroll") for (int m = 0; m < 4; ++m) _Pragma("unroll") for (int k = 0; k < 2; ++k) dst[m][k] = *(const LAS bf16x8*)(lds + PG8_SA(b, h) + aoff + m * 2048 + k * 1024); } while (0)
#define PG8_LDB(dst, b, h) do { _Pragma("unroll") for (int n = 0; n < 2; ++n) _Pragma("unroll") for (int k = 0; k < 2; ++k) dst[n][k] = *(const LAS bf16x8*)(lds + PG8_SB(b, h) + boff + n * 2048 + k * 1024); } while (0)
#define PG8_MMA(ai, bj, At, Bt) do { __builtin_amdgcn_s_setprio(1); _Pragma("unroll") for (int m = 0; m < 4; ++m) _Pragma("unroll") for (int n = 0; n < 2; ++n) _Pragma("unroll") for (int k = 0; k < 2; ++k) \
        acc[ai][bj][m][n] = __builtin_amdgcn_mfma_f32_16x16x32_bf16(Bt[n][k], At[m][k], acc[ai][bj][m][n], 0, 0, 0); __builtin_amdgcn_s_setprio(0); } while (0)
#define PG8_WAIT_V(n) asm volatile("s_waitcnt vmcnt(" #n ")" ::: "memory")
#define PG8_WAIT_L(n) asm volatile("s_waitcnt lgkmcnt(" #n ")" ::: "memory")
#define PG8_BAR __builtin_amdgcn_s_barrier()
#define PG8_SCHED __builtin_amdgcn_sched_barrier(0)
    Unit cur, nxt; int ui = 0;
    if (!S.next(0, cur)) return;
    f32x4 acc[2][2][4][2];
#pragma unroll
    for (int a = 0; a < 2; ++a)
#pragma unroll
        for (int b = 0; b < 2; ++b)
#pragma unroll
            for (int m = 0; m < 4; ++m)
#pragma unroll
                for (int n = 0; n < 2; ++n) acc[a][b][m][n] = (f32x4){0.f, 0.f, 0.f, 0.f};
    bf16x8 At[4][2], B0[2][2], B1[2][2];
    const char* cA = (const char*)g.A + (size_t)cur.pm * tstep; const char* cB = (const char*)g.Bt + (size_t)cur.pn * tstep;
    PG8_STAGE(PG8_SB(0, 0), cB, voffB); PG8_STAGE(PG8_SA(0, 0), cA, voffA); PG8_STAGE(PG8_SB(0, 1), cB + hstep, voffB); PG8_STAGE(PG8_SA(0, 1), cA + hstep, voffA);
    if (wr == 1) PG8_BAR;
    PG8_WAIT_V(4); PG8_BAR;
    PG8_STAGE(PG8_SB(1, 0), cB + kstep, voffB); PG8_STAGE(PG8_SA(1, 0), cA + kstep, voffA); PG8_STAGE(PG8_SB(1, 1), cB + hstep + kstep, voffB);
    PG8_WAIT_V(6); PG8_BAR;
    for (;;) {
        const int nj = (ui + 1) & 1;
        const bool has_next = S.next((ui + 1) >> 1, nxt);
        const char* nAb = nj ? (const char*)g1.A : (const char*)g.A; const char* nBb = nj ? (const char*)g1.Bt : (const char*)g.Bt;
        const char* nA = has_next ? nAb + (size_t)nxt.pm * tstep : cA; const char* nB = has_next ? nBb + (size_t)nxt.pn * tstep : cB;
        for (int t = 0; t < nt; t += 2) {
            const bool last = (t == nt - 2);
            const char* a1 = cA + (size_t)(t + 1) * kstep;
            const char* a2 = last ? nA : cA + (size_t)(t + 2) * kstep; const char* b2 = last ? nB : cB + (size_t)(t + 2) * kstep;
            const char* a3 = a2 + kstep; const char* b3 = b2 + kstep;
            PG8_LDB(B0, 0, 0); PG8_SCHED; PG8_LDA(At, 0, 0); PG8_STAGE(PG8_SA(1, 1), a1 + hstep, voffA);
            PG8_WAIT_L(8); PG8_BAR; PG8_WAIT_L(0); PG8_MMA(0, 0, At, B0); PG8_BAR; PG8_SCHED;
            PG8_LDB(B1, 0, 1); PG8_STAGE(PG8_SB(0, 0), b2, voffB);
            PG8_BAR; PG8_WAIT_L(0); PG8_MMA(0, 1, At, B1); PG8_BAR;
            PG8_LDA(At, 0, 1); PG8_STAGE(PG8_SA(0, 0), a2, voffA);
            PG8_BAR; PG8_WAIT_L(0); PG8_MMA(1, 0, At, B0); PG8_BAR; PG8_SCHED;
            PG8_STAGE(PG8_SB(0, 1), b2 + hstep, voffB);
            PG8_WAIT_V(6); PG8_BAR; PG8_MMA(1, 1, At, B1); PG8_BAR;
            PG8_LDB(B0, 1, 0); PG8_SCHED; PG8_LDA(At, 1, 0); PG8_STAGE(PG8_SA(0, 1), a2 + hstep, voffA);
            PG8_WAIT_L(8); PG8_BAR; PG8_WAIT_L(0); PG8_MMA(0, 0, At, B0); PG8_BAR; PG8_SCHED;
            PG8_LDB(B1, 1, 1); PG8_STAGE(PG8_SB(1, 0), b3, voffB);
            PG8_BAR; PG8_WAIT_L(0); PG8_MMA(0, 1, At, B1); PG8_BAR;
            PG8_LDA(At, 1, 1); PG8_STAGE(PG8_SA(1, 0), a3, voffA);
            PG8_BAR; PG8_WAIT_L(0); PG8_MMA(1, 0, At, B0); PG8_BAR; PG8_SCHED;
            PG8_STAGE(PG8_SB(1, 1), b3 + hstep, voffB);
            PG8_WAIT_V(6); PG8_BAR; PG8_MMA(1, 1, At, B1); PG8_BAR;
        }
        if (ui & 1) E1(acc, cur, wr, wc, fr, fq); else E0(acc, cur, wr, wc, fr, fq);
        if (!has_next) break;
#pragma unroll
        for (int a = 0; a < 2; ++a)
#pragma unroll
            for (int b = 0; b < 2; ++b)
#pragma unroll
                for (int m = 0; m < 4; ++m)
#pragma unroll
                    for (int n = 0; n < 2; ++n) acc[a][b][m][n] = (f32x4){0.f, 0.f, 0.f, 0.f};
        cur = nxt; cA = nA; cB = nB; ++ui;
    }
    PG8_WAIT_V(0);
    if (wr == 0) PG8_BAR;
    PG8_BAR;
#undef PG8_SA
#undef PG8_SB
#undef PG8_STAGE
#undef PG8_LDA
#undef PG8_LDB
#undef PG8_MMA
#undef PG8_WAIT_V
#undef PG8_WAIT_L
#undef PG8_BAR
#undef PG8_SCHED
}
}
using pg8::Unit;
typedef const f32x4 (&AccRef)[2][2][4][2];

template <bool RS> struct EpiSwiGLU {
    bf16_t* G; const float* ss;
    DI void operator()(AccRef acc, const Unit& u, int wr, int wc, int fr, int fq) const {
        const int row0 = u.pm * 256 + wr * 64 + fr, col = u.pn * 128 + wc * 32 + 8 * fq;
        RowScales rsc; if (RS) rsc = load_rowscales(ss, row0);
#pragma unroll
        for (int ai = 0; ai < 2; ++ai)
#pragma unroll
            for (int m = 0; m < 4; ++m) {
                const int row = row0 + ai * 128 + m * 16;
                const float r = RS ? rsc.r[ai][m] : 1.0f;
                const f32x4 a0 = acc[ai][0][m][0] * r, a1 = acc[ai][0][m][1] * r, b0 = acc[ai][1][m][0] * r, b1 = acc[ai][1][m][1] * r;
                u32x4 w;
                w.x = pk_bf16(fast_silu(a0[0]) * b0[0], fast_silu(a0[1]) * b0[1]); w.y = pk_bf16(fast_silu(a0[2]) * b0[2], fast_silu(a0[3]) * b0[3]);
                w.z = pk_bf16(fast_silu(a1[0]) * b1[0], fast_silu(a1[1]) * b1[1]); w.w = pk_bf16(fast_silu(a1[2]) * b1[2], fast_silu(a1[3]) * b1[3]);
                *(u32x4*)(G + (size_t)row * DFF + col) = w;
            }
    }
};
template <bool STATS, bool HALFSTEP> struct EpiRes {
    const float* base; float* out; bf16_t* xnb; float* ss;
    DI void operator()(AccRef acc, const Unit& u, int wr, int wc, int fr, int fq) const {
        const float scale = HALFSTEP ? 0.5f : 1.0f;
        const int row0 = u.pm * 256 + wr * 64 + fr, col0 = u.pn * 256 + wc * 32 + 8 * fq;
#pragma unroll
        for (int ai = 0; ai < 2; ++ai) {
            f32x4 bv[4][2][2];
#pragma unroll
            for (int m = 0; m < 4; ++m)
#pragma unroll
                for (int bj = 0; bj < 2; ++bj) {
                    const size_t o = (size_t)(row0 + ai * 128 + m * 16) * DM + col0 + bj * 128;
                    bv[m][bj][0] = *(const f32x4*)(base + o); bv[m][bj][1] = *(const f32x4*)(base + o + 4);
                }
#pragma unroll
            for (int m = 0; m < 4; ++m) {
                const int row = row0 + ai * 128 + m * 16;
                float q = 0.f;
#pragma unroll
                for (int bj = 0; bj < 2; ++bj) {
                    const size_t o = (size_t)row * DM + col0 + bj * 128;
                    const f32x4 r0 = bv[m][bj][0] + scale * acc[ai][bj][m][0], r1 = bv[m][bj][1] + scale * acc[ai][bj][m][1];
                    *(f32x4*)(out + o) = r0;
                    *(f32x4*)(out + o + 4) = r1;
                    if (STATS) {
                        u32x4 w; w.x = pk_bf16(r0[0], r0[1]); w.y = pk_bf16(r0[2], r0[3]); w.z = pk_bf16(r1[0], r1[1]); w.w = pk_bf16(r1[2], r1[3]);
                        *(u32x4*)(xnb + o) = w;
                        q += r0[0] * r0[0] + r0[1] * r0[1] + r0[2] * r0[2] + r0[3] * r0[3] + r1[0] * r1[0] + r1[1] * r1[1] + r1[2] * r1[2] + r1[3] * r1[3];
                    }
                }
                if (STATS) { q += __shfl_xor(q, 16); q += __shfl_xor(q, 32); if (fq == 0) atomicAdd(ss + row, q); }
            }
        }
    }
};
template <bool STATS, bool HALFSTEP, bool BASEF32> struct EpiRes16 {
    const float* basef; bf16_t* xnb; float* ss;
    DI void operator()(AccRef acc, const Unit& u, int wr, int wc, int fr, int fq) const {
        const float scale = HALFSTEP ? 0.5f : 1.0f;
        const int row0 = u.pm * 256 + wr * 64 + fr, col0 = u.pn * 256 + wc * 32 + 8 * fq;
#pragma unroll
        for (int ai = 0; ai < 2; ++ai) {
            f32x4 bv[4][2][2];
#pragma unroll
            for (int m = 0; m < 4; ++m)
#pragma unroll
                for (int bj = 0; bj < 2; ++bj) {
                    const size_t o = (size_t)(row0 + ai * 128 + m * 16) * DM + col0 + bj * 128;
                    if (BASEF32) { bv[m][bj][0] = *(const f32x4*)(basef + o); bv[m][bj][1] = *(const f32x4*)(basef + o + 4); }
                    else { const u32x4 h = *(const u32x4*)(xnb + o); bv[m][bj][0] = bf_lo4(h); bv[m][bj][1] = bf_hi4(h); }
                }
#pragma unroll
            for (int m = 0; m < 4; ++m) {
                const int row = row0 + ai * 128 + m * 16;
                float q = 0.f;
#pragma unroll
                for (int bj = 0; bj < 2; ++bj) {
                    const size_t o = (size_t)row * DM + col0 + bj * 128;
                    const f32x4 r0 = bv[m][bj][0] + scale * acc[ai][bj][m][0], r1 = bv[m][bj][1] + scale * acc[ai][bj][m][1];
                    u32x4 w; w.x = pk_bf16(r0[0], r0[1]); w.y = pk_bf16(r0[2], r0[3]); w.z = pk_bf16(r1[0], r1[1]); w.w = pk_bf16(r1[2], r1[3]);
                    *(u32x4*)(xnb + o) = w;
                    if (STATS) q += r0[0] * r0[0] + r0[1] * r0[1] + r0[2] * r0[2] + r0[3] * r0[3] + r1[0] * r1[0] + r1[1] * r1[1] + r1[2] * r1[2] + r1[3] * r1[3];
                }
                if (STATS) { q += __shfl_xor(q, 16); q += __shfl_xor(q, 32); if (fq == 0) atomicAdd(ss + row, q); }
            }
        }
    }
};
struct EpiResFinal {
    static constexpr int NST = 16;
    const float* base; bf16_t* out16;
    DI void operator()(AccRef acc, const Unit& u, int wr, int wc, int fr, int fq) const {
        const int row0 = u.pm * 256 + wr * 64 + fr, col0 = u.pn * 256 + wc * 32 + 8 * fq;
#pragma unroll
        for (int ai = 0; ai < 2; ++ai) {
            f32x4 bv[4][2][2];
#pragma unroll
            for (int m = 0; m < 4; ++m)
#pragma unroll
                for (int bj = 0; bj < 2; ++bj) {
                    const size_t o = (size_t)(row0 + ai * 128 + m * 16) * DM + col0 + bj * 128;
                    bv[m][bj][0] = *(const f32x4*)(base + o); bv[m][bj][1] = *(const f32x4*)(base + o + 4);
                }
#pragma unroll
            for (int m = 0; m < 4; ++m)
#pragma unroll
                for (int bj = 0; bj < 2; ++bj) {
                    const size_t o = (size_t)(row0 + ai * 128 + m * 16) * DM + col0 + bj * 128;
                    const f32x4 r0 = bv[m][bj][0] + 0.5f * acc[ai][bj][m][0], r1 = bv[m][bj][1] + 0.5f * acc[ai][bj][m][1];
                    u32x4 w; w.x = pk_bf16(r0[0], r0[1]); w.y = pk_bf16(r0[2], r0[3]); w.z = pk_bf16(r1[0], r1[1]); w.w = pk_bf16(r1[2], r1[3]);
                    *(u32x4*)(out16 + o) = w;
                }
        }
    }
};
struct EpiQK {
    bf16_t* qkoA; bf16_t* qkoB; const float* cosT; const float* sinT; const float* ss;
    DI void operator()(AccRef acc, const Unit& u, int wr, int wc, int fr, int fq) const {
        const int X = u.pn >> 2, h = u.pn & 3, isk = wc >> 1, i0 = (wc & 1) * 32 + 8 * fq;
        bf16_t* dst = (X ? qkoB : qkoA) + h * 256 + isk * 128 + i0;
        const float qs0 = isk ? 1.0f : 0.08838834764831845f;
        const int row0 = u.pm * 256 + wr * 64 + fr;
        const RowScales rsc = load_rowscales(ss, row0);
#pragma unroll
        for (int ai = 0; ai < 2; ++ai) {
            f32x4 cs[4][2], sn[4][2];
            if (X == 0) {
#pragma unroll
                for (int m = 0; m < 4; ++m) {
                    const int pos = (row0 + ai * 128 + m * 16) & (SEQ - 1);
                    cs[m][0] = *(const f32x4*)(cosT + pos * 64 + i0); cs[m][1] = *(const f32x4*)(cosT + pos * 64 + i0 + 4);
                    sn[m][0] = *(const f32x4*)(sinT + pos * 64 + i0); sn[m][1] = *(const f32x4*)(sinT + pos * 64 + i0 + 4);
                }
            } else {
#pragma unroll
                for (int m = 0; m < 4; ++m) { cs[m][0] = cs[m][1] = (f32x4){1.f, 1.f, 1.f, 1.f}; sn[m][0] = sn[m][1] = (f32x4){0.f, 0.f, 0.f, 0.f}; }
            }
#pragma unroll
            for (int m = 0; m < 4; ++m) {
                const int row = row0 + ai * 128 + m * 16;
                const float qs = qs0 * rsc.r[ai][m];
                const f32x4 x1 = acc[ai][0][m][0], x2 = acc[ai][1][m][0], y1 = acc[ai][0][m][1], y2 = acc[ai][1][m][1];
                const f32x4 a1 = (x1 * cs[m][0] - x2 * sn[m][0]) * qs, a2 = (x2 * cs[m][0] + x1 * sn[m][0]) * qs;
                const f32x4 b1 = (y1 * cs[m][1] - y2 * sn[m][1]) * qs, b2 = (y2 * cs[m][1] + y1 * sn[m][1]) * qs;
                u32x4 w1, w2;
                w1.x = pk_bf16(a1[0], a1[1]); w1.y = pk_bf16(a1[2], a1[3]); w1.z = pk_bf16(b1[0], b1[1]); w1.w = pk_bf16(b1[2], b1[3]);
                w2.x = pk_bf16(a2[0], a2[1]); w2.y = pk_bf16(a2[2], a2[3]); w2.z = pk_bf16(b2[0], b2[1]); w2.w = pk_bf16(b2[2], b2[3]);
                *(u32x4*)(dst + (size_t)row * 1024) = w1;
                *(u32x4*)(dst + (size_t)row * 1024 + 64) = w2;
            }
        }
    }
};
struct EpiVT {
    bf16_t* vtA; bf16_t* vtB; const float* ss;
    DI void operator()(AccRef acc, const Unit& u, int wr, int wc, int fr, int fq) const {
        f32x4 ts[2][2];
#pragma unroll
        for (int bj = 0; bj < 2; ++bj) { const int tok = u.pn * 256 + bj * 128 + wc * 32 + 8 * fq; ts[bj][0] = *(const f32x4*)(ss + tok); ts[bj][1] = *(const f32x4*)(ss + tok + 4); }
#pragma unroll
        for (int bj = 0; bj < 2; ++bj)
#pragma unroll
            for (int n = 0; n < 2; ++n)
#pragma unroll
                for (int e = 0; e < 4; ++e) ts[bj][n][e] = rsqrtf(ts[bj][n][e] * (1.0f / 1024.0f) + 1e-6f);
#pragma unroll
        for (int ai = 0; ai < 2; ++ai)
#pragma unroll
            for (int m = 0; m < 4; ++m) {
                const int R = u.pm * 256 + ai * 128 + wr * 64 + m * 16 + fr, X = R >> 10, hv = R & 1023;
#pragma unroll
                for (int bj = 0; bj < 2; ++bj) {
                    const int tok = u.pn * 256 + bj * 128 + wc * 32 + 8 * fq, b = tok >> 13, s = tok & (SEQ - 1);
                    bf16_t* dst = (X ? vtB : vtA) + ((size_t)(((b * 4 + (hv >> 8)) * 128 + (s >> 6)) * 256 + (hv & 255))) * 64 + (s & 63);
                    const f32x4 v0 = acc[ai][bj][m][0] * ts[bj][0], v1 = acc[ai][bj][m][1] * ts[bj][1];
                    u32x4 w; w.x = pk_bf16(v0[0], v0[1]); w.y = pk_bf16(v0[2], v0[3]); w.z = pk_bf16(v1[0], v1[1]); w.w = pk_bf16(v1[2], v1[3]);
                    *(u32x4*)dst = w;
                }
            }
    }
};
struct EpiRGate {
    bf16_t* oA; bf16_t* oB; const float* ss;
    DI void operator()(AccRef acc, const Unit& u, int wr, int wc, int fr, int fq) const {
        const int row0 = u.pm * 256 + wr * 64 + fr;
        bf16_t* O = (u.pn < 4 ? oA : oB) + (u.pn & 3) * 256 + wc * 32 + 8 * fq;
        const RowScales rsc = load_rowscales(ss, row0);
#pragma unroll
        for (int ai = 0; ai < 2; ++ai) {
            u32x4 ov[4][2];
#pragma unroll
            for (int m = 0; m < 4; ++m)
#pragma unroll
                for (int bj = 0; bj < 2; ++bj) ov[m][bj] = *(const u32x4*)(O + (size_t)(row0 + ai * 128 + m * 16) * 1024 + bj * 128);
#pragma unroll
            for (int m = 0; m < 4; ++m)
#pragma unroll
                for (int bj = 0; bj < 2; ++bj) {
                    bf16_t* p = O + (size_t)(row0 + ai * 128 + m * 16) * 1024 + bj * 128;
                    const float rs = rsc.r[ai][m];
                    const u32x4 o = ov[m][bj]; const f32x4 r0 = acc[ai][bj][m][0] * rs, r1 = acc[ai][bj][m][1] * rs;
                    u32x4 w;
                    w.x = pk_bf16(fast_silu(r0[0]) * bf_lo(o.x), fast_silu(r0[1]) * bf_hi(o.x)); w.y = pk_bf16(fast_silu(r0[2]) * bf_lo(o.y), fast_silu(r0[3]) * bf_hi(o.y));
                    w.z = pk_bf16(fast_silu(r1[0]) * bf_lo(o.z), fast_silu(r1[1]) * bf_hi(o.z)); w.w = pk_bf16(fast_silu(r1[2]) * bf_lo(o.w), fast_silu(r1[3]) * bf_hi(o.w));
                    *(u32x4*)p = w;
                }
        }
    }
};
struct EpiGates {
    bf16_t* gab; const float* ss;
    DI void operator()(AccRef acc, const Unit& u, int wr, int wc, int fr, int fq) const {
        const int row0 = u.pm * 256 + wr * 64 + fr;
        bf16_t* Gp = gab + (size_t)(u.pm * 8 + u.pn) * 65536 + (wr * 64 + fr) * 256 + wc * 32 + 8 * fq;
        const RowScales rsc = load_rowscales(ss, row0);
#pragma unroll
        for (int ai = 0; ai < 2; ++ai)
#pragma unroll
            for (int m = 0; m < 4; ++m)
#pragma unroll
                for (int bj = 0; bj < 2; ++bj) {
                    const float rs = rsc.r[ai][m];
                    const f32x4 r0 = acc[ai][bj][m][0] * rs, r1 = acc[ai][bj][m][1] * rs;
                    u32x4 w;
                    w.x = pk_bf16(fast_sigmoid(r0[0]), fast_sigmoid(r0[1])); w.y = pk_bf16(fast_sigmoid(r0[2]), fast_sigmoid(r0[3]));
                    w.z = pk_bf16(fast_sigmoid(r1[0]), fast_sigmoid(r1[1])); w.w = pk_bf16(fast_sigmoid(r1[2]), fast_sigmoid(r1[3]));
                    *(u32x4*)(Gp + (ai * 128 + m * 16) * 256 + bj * 128) = w;
                }
    }
};
template <int SECOND> struct EpiMerge {
    const bf16_t* gab; bf16_t* mrg;
    DI void operator()(AccRef acc, const Unit& u, int wr, int wc, int fr, int fq) const {
        const int row0 = u.pm * 256 + wr * 64 + fr, col0 = u.pn * 256 + wc * 32 + 8 * fq;
#pragma unroll
        for (int ai = 0; ai < 2; ++ai)
#pragma unroll
            for (int mh = 0; mh < 2; ++mh) {
                u32x4 gv[2][2], mv[2][2];
#pragma unroll
                for (int mm = 0; mm < 2; ++mm)
#pragma unroll
                    for (int bj = 0; bj < 2; ++bj) {
                        const size_t row = (size_t)(row0 + ai * 128 + (mh * 2 + mm) * 16); const int col = col0 + bj * 128;
                        gv[mm][bj] = *(const u32x4*)(gab + (size_t)(u.pm * 8 + SECOND * 4 + u.pn) * 65536 + (wr * 64 + fr + ai * 128 + (mh * 2 + mm) * 16) * 256 + wc * 32 + 8 * fq + bj * 128);
                        if (SECOND) mv[mm][bj] = *(const u32x4*)(mrg + row * 1024 + col);
                    }
#pragma unroll
                for (int mm = 0; mm < 2; ++mm)
#pragma unroll
                    for (int bj = 0; bj < 2; ++bj) {
                        const int m = mh * 2 + mm;
                        const size_t row = (size_t)(row0 + ai * 128 + m * 16); const int col = col0 + bj * 128;
                        const u32x4 gt = gv[mm][bj];
                        const f32x4 r0 = acc[ai][bj][m][0], r1 = acc[ai][bj][m][1];
                        float v[8] = {bf_lo(gt.x) * r0[0], bf_hi(gt.x) * r0[1], bf_lo(gt.y) * r0[2], bf_hi(gt.y) * r0[3], bf_lo(gt.z) * r1[0], bf_hi(gt.z) * r1[1], bf_lo(gt.w) * r1[2], bf_hi(gt.w) * r1[3]};
                        if (SECOND) { const u32x4 o = mv[mm][bj]; v[0] += bf_lo(o.x); v[1] += bf_hi(o.x); v[2] += bf_lo(o.y); v[3] += bf_hi(o.y); v[4] += bf_lo(o.z); v[5] += bf_hi(o.z); v[6] += bf_lo(o.w); v[7] += bf_hi(o.w); }
                        u32x4 w; w.x = pk_bf16(v[0], v[1]); w.y = pk_bf16(v[2], v[3]); w.z = pk_bf16(v[4], v[5]); w.w = pk_bf16(v[6], v[7]);
                        *(u32x4*)(mrg + row * 1024 + col) = w;
                    }
            }
    }
};

template <class Epi> DI void run_gemm(LAS unsigned char* lds, const bf16_t* A, const bf16_t* Bt, int M, int N, int K, const Epi E) {
    pg8::Gemm g; g.A = A; g.Bt = Bt; g.M = M; g.N = N; g.K = K;
    pg8::StaticOrder S; S.init(M, N, (int)gridDim.x, (int)blockIdx.x);
    pg8::gemm_phase<Epi>(lds, g, S, E);
}

template <class Epi0, class Epi1> DI void run_gemm_dual(LAS unsigned char* lds, const bf16_t* A0, const bf16_t* Bt0, const bf16_t* A1, const bf16_t* Bt1, int M, int N, int K, const Epi0 E0, const Epi1 E1) {
    pg8::Gemm g0; g0.A = A0; g0.Bt = Bt0; g0.M = M; g0.N = N; g0.K = K;
    pg8::Gemm g1 = g0; g1.A = A1; g1.Bt = Bt1;
    pg8::StaticOrder S; S.init(M, N, (int)gridDim.x, (int)blockIdx.x);
    pg8::gemm_phase_dual<Epi0, Epi1>(lds, g0, g1, S, E0, E1);
}

DI void wprep_tile(LAS unsigned char* lds, const float* src, int col0, int ldw, int K, bf16_t* dst, int r0, int k0, const float* ksc) {
    const int t = opaque_tid(), c = t & 63, kk = t >> 6;
    float v[8];
#pragma unroll
    for (int i = 0; i < 8; ++i) v[i] = src[(size_t)(k0 + kk * 8 + i) * ldw + col0 + c];
    if (ksc) {
#pragma unroll
        for (int i = 0; i < 8; ++i) v[i] *= ksc[k0 + kk * 8 + i];
    }
    u32x4 w; w.x = pk_bf16(v[0], v[1]); w.y = pk_bf16(v[2], v[3]); w.z = pk_bf16(v[4], v[5]); w.w = pk_bf16(v[6], v[7]);
    *(LAS u32x4*)(lds + c * 144 + kk * 16) = w;
    __syncthreads();
    const int row = t >> 3, seg = t & 7;
    const u32x4 o = *(const LAS u32x4*)(lds + row * 144 + seg * 16);
    *(u32x4*)(dst + (size_t)(r0 + row) * K + k0 + seg * 8) = o;
    __syncthreads();
}
DI void wprep_tile4(LAS unsigned char* lds, const float* src, int col0, int ldw, int K, bf16_t* dst, int r0, int k0, const float* ksc) {
    const int t = opaque_tid(), c = t & 63, kk = t >> 6;
    float v[4][8];
#pragma unroll
    for (int q = 0; q < 4; ++q)
#pragma unroll
        for (int i = 0; i < 8; ++i) v[q][i] = src[(size_t)(k0 + q * 64 + kk * 8 + i) * ldw + col0 + c];
    if (ksc) {
#pragma unroll
        for (int q = 0; q < 4; ++q)
#pragma unroll
            for (int i = 0; i < 8; ++i) v[q][i] *= ksc[k0 + q * 64 + kk * 8 + i];
    }
#pragma unroll
    for (int q = 0; q < 4; ++q) {
        u32x4 w; w.x = pk_bf16(v[q][0], v[q][1]); w.y = pk_bf16(v[q][2], v[q][3]); w.z = pk_bf16(v[q][4], v[q][5]); w.w = pk_bf16(v[q][6], v[q][7]);
        *(LAS u32x4*)(lds + q * 9216 + c * 144 + kk * 16) = w;
    }
    __syncthreads();
    const int row = t >> 3, seg = t & 7;
#pragma unroll
    for (int q = 0; q < 4; ++q) {
        const u32x4 o = *(const LAS u32x4*)(lds + q * 9216 + row * 144 + seg * 16);
        *(u32x4*)(dst + (size_t)(r0 + row) * K + k0 + q * 64 + seg * 8) = o;
    }
    __syncthreads();
}
template <class F> DI void wjob(LAS unsigned char* lds, int& off, const int G, const int c, int nrb, int nkb, int K, int ldw, bf16_t* dst, const float* src, const float* ksc, F&& mapf) {
    const int nkb4 = nkb >> 2, ntl = nrb * nkb4;
    const int start = ((c - off) % G + G) % G;
    for (int t = start; t < ntl; t += G) { const int rb = t / nkb4, kb = t % nkb4; int col0, drow; mapf(rb, col0, drow); wprep_tile4(lds, src, col0, ldw, K, dst, drow, kb * 256, ksc); }
    off += ntl;
}
template <int PART> DI void wprep_jobs(const Args& a, LAS unsigned char* lds, const int G, const int c) {
    unsigned char* ws = a.ws;
    const float* win = a.in[6];
    int off = 0;
    auto mapW1 = [](int rb, int& col0, int& drow) { col0 = rb * 64; drow = (rb >> 1) * 256 + (rb & 1) * 64; };
    auto mapW3 = [](int rb, int& col0, int& drow) { col0 = rb * 64; drow = (rb >> 1) * 256 + 128 + (rb & 1) * 64; };
    auto mapId = [](int rb, int& col0, int& drow) { col0 = rb * 64; drow = rb * 64; };
    if (PART == 0) {
        wjob(lds, off, G, c, 44, 16, 1024, DFF, (bf16_t*)(ws + WS_W13_1), a.in[2], nullptr, mapW1);
        wjob(lds, off, G, c, 44, 16, 1024, DFF, (bf16_t*)(ws + WS_W13_1), a.in[3], nullptr, mapW3);
        wjob(lds, off, G, c, 16, 44, DFF, 1024, (bf16_t*)(ws + WS_W2T_1), a.in[4], nullptr, mapId);
        wjob(lds, off, G, c, 32, 16, 1024, DIN, (bf16_t*)(ws + WS_WQK), win, a.in[5], [](int rb, int& col0, int& drow) { const int r0 = rb * 64, tile = r0 >> 8, X = tile >> 2, h = tile & 3, seg = (r0 & 255) >> 6;
            col0 = (X ? 3072 : 0) + ((seg & 1) ? 512 : 0) + h * 128 + (seg >> 1) * 64; drow = r0; });
        wjob(lds, off, G, c, 32, 16, 1024, DIN, (bf16_t*)(ws + WS_WV), win, a.in[5], [](int rb, int& col0, int& drow) { const int r0 = rb * 64; col0 = (r0 < 1024) ? 1024 + r0 : 4096 + (r0 - 1024); drow = r0; });
    } else {
        wjob(lds, off, G, c, 64, 16, 1024, DIN, (bf16_t*)(ws + WS_WRG), win, a.in[5], [](int rb, int& col0, int& drow) { const int r0 = rb * 64, q = r0 >> 10, r = r0 & 1023; col0 = (q == 0 ? 2048 : q == 1 ? 5120 : q == 2 ? 6160 : 7184) + r; drow = r0; });
        wjob(lds, off, G, c, 16, 16, 1024, 1024, (bf16_t*)(ws + WS_WBR), a.in[10], nullptr, mapId);
        wjob(lds, off, G, c, 16, 16, 1024, 1024, (bf16_t*)(ws + WS_WBG), a.in[11], nullptr, mapId);
        wjob(lds, off, G, c, 16, 16, 1024, 1024, (bf16_t*)(ws + WS_WOUT), a.in[12], nullptr, mapId);
        wjob(lds, off, G, c, 44, 16, 1024, DFF, (bf16_t*)(ws + WS_W13_2), a.in[14], a.in[13], mapW1);
        wjob(lds, off, G, c, 44, 16, 1024, DFF, (bf16_t*)(ws + WS_W13_2), a.in[15], a.in[13], mapW3);
        wjob(lds, off, G, c, 16, 44, DFF, 1024, (bf16_t*)(ws + WS_W2T_2), a.in[16], nullptr, mapId);
    }
}
DI void wprep_phase(const Args& a, LAS unsigned char* lds) {
    unsigned char* ws = a.ws;
    const float* win = a.in[6];
    wprep_jobs<0>(a, lds, (int)gridDim.x, (int)blockIdx.x);
    {
        bf16_t* wlr = (bf16_t*)(ws + WS_WLR);
        for (int i = blockIdx.x * 512 + threadIdx.x; i < 16 * 1024; i += gridDim.x * 512) { const int r = i >> 10, k = i & 1023; wlr[i] = (bf16_t)(pk_bf16(win[(size_t)k * DIN + 6144 + r] * a.in[5][k], 0.f) & 0xffffu); }
    }
    { float* z = (float*)(ws + WS_SS1); for (int i = blockIdx.x * 512 + threadIdx.x; i < 2 * NTOK; i += gridDim.x * 512) z[i] = 0.f; }
    {
        float* ct = (float*)(ws + WS_ROTC); float* st = (float*)(ws + WS_ROTS);
        for (int i = blockIdx.x * 512 + threadIdx.x; i < SEQ * 64; i += gridDim.x * 512) {
            const int pos = i >> 6, f = i & 63;
            double inv = 1.0, cb = 0.8659643233600653;
#pragma unroll
            for (int bit = 0; bit < 6; ++bit) { if ((f >> bit) & 1) inv *= cb; cb *= cb; }
            const double rev = (double)pos * inv * 0.15915494309189535;
            const float r = (float)(rev - rint(rev));
            ct[i] = __builtin_amdgcn_cosf(r); st[i] = __builtin_amdgcn_sinf(r);
        }
    }
}

template <bool OUT_BF16> DI void rmsnorm_phase(const float* src, const float* w, void* dstv) {
    const int tid_ = opaque_tid(), lane = tid_ & 63, wid = tid_ >> 6;
    f32x4 wv[4];
#pragma unroll
    for (int j = 0; j < 4; ++j) wv[j] = *(const f32x4*)(w + j * 256 + lane * 4);
    for (int row = (blockIdx.x * 8 + wid) * 2; row < NTOK; row += gridDim.x * 16) {
        f32x4 v[2][4]; float ss[2] = {0.f, 0.f};
#pragma unroll
        for (int r = 0; r < 2; ++r)
#pragma unroll
            for (int j = 0; j < 4; ++j) v[r][j] = *(const f32x4*)(src + (size_t)(row + r) * DM + j * 256 + lane * 4);
#pragma unroll
        for (int r = 0; r < 2; ++r)
#pragma unroll
            for (int j = 0; j < 4; ++j) ss[r] += v[r][j][0] * v[r][j][0] + v[r][j][1] * v[r][j][1] + v[r][j][2] * v[r][j][2] + v[r][j][3] * v[r][j][3];
#pragma unroll
        for (int o = 32; o >= 1; o >>= 1) { ss[0] += __shfl_xor(ss[0], o); ss[1] += __shfl_xor(ss[1], o); }
#pragma unroll
        for (int r = 0; r < 2; ++r) {
            const float rs = rsqrtf(ss[r] * (1.0f / 1024.0f) + 1e-6f);
#pragma unroll
            for (int j = 0; j < 4; ++j) {
                const f32x4 y = v[r][j] * rs * wv[j];
                if (OUT_BF16) { u32x2 o; o.x = pk_bf16(y[0], y[1]); o.y = pk_bf16(y[2], y[3]); *(u32x2*)((bf16_t*)dstv + (size_t)(row + r) * DM + j * 256 + lane * 4) = o; }
                else *(f32x4*)((float*)dstv + (size_t)(row + r) * DM + j * 256 + lane * 4) = y;
            }
        }
    }
}

DI void final_norm_phase(const bf16_t* src, const float* w, float* dst) {
    const int tid_ = opaque_tid(), lane = tid_ & 63, wid = tid_ >> 6;
    f32x4 wv[2][2];
#pragma unroll
    for (int j = 0; j < 2; ++j) { wv[j][0] = *(const f32x4*)(w + j * 512 + lane * 8); wv[j][1] = *(const f32x4*)(w + j * 512 + lane * 8 + 4); }
    for (int row = (blockIdx.x * 8 + wid) * 2; row < NTOK; row += gridDim.x * 16) {
        u32x4 hv[2][2];
#pragma unroll
        for (int r = 0; r < 2; ++r)
#pragma unroll
            for (int j = 0; j < 2; ++j) hv[r][j] = *(const u32x4*)(src + (size_t)(row + r) * DM + j * 512 + lane * 8);
        float ss[2] = {0.f, 0.f};
        f32x4 v[2][2][2];
#pragma unroll
        for (int r = 0; r < 2; ++r)
#pragma unroll
            for (int j = 0; j < 2; ++j) {
                v[r][j][0] = bf_lo4(hv[r][j]); v[r][j][1] = bf_hi4(hv[r][j]);
#pragma unroll
                for (int e = 0; e < 4; ++e) ss[r] += v[r][j][0][e] * v[r][j][0][e] + v[r][j][1][e] * v[r][j][1][e];
            }
#pragma unroll
        for (int o = 32; o >= 1; o >>= 1) { ss[0] += __shfl_xor(ss[0], o); ss[1] += __shfl_xor(ss[1], o); }
#pragma unroll
        for (int r = 0; r < 2; ++r) {
            const float rs = rsqrtf(ss[r] * (1.0f / 1024.0f) + 1e-6f);
#pragma unroll
            for (int j = 0; j < 2; ++j) {
                *(f32x4*)(dst + (size_t)(row + r) * DM + j * 512 + lane * 8) = v[r][j][0] * rs * wv[j][0];
                *(f32x4*)(dst + (size_t)(row + r) * DM + j * 512 + lane * 8 + 4) = v[r][j][1] * rs * wv[j][1];
            }
        }
    }
}

DI void cum_phase(const Args& a, LAS unsigned char* lds) {
    const bf16_t* xn = (const bf16_t*)(a.ws + WS_XN); const bf16_t* wlr = (const bf16_t*)(a.ws + WS_WLR); _Float16* cumo = (_Float16*)(a.ws + WS_CUM);
    const int tid = opaque_tid(), lane = tid & 63, wid = tid >> 6, fr = lane & 15, g = lane >> 4;
    LAS float* lrp = (LAS float*)lds;
    const float* ss1 = (const float*)(a.ws + WS_SS1);
    float w2c[16];
#pragma unroll
    for (int r = 0; r < 16; ++r) w2c[r] = a.in[7][r * 512 + tid];
    const float bias = a.in[8][tid];
    for (int chunk = blockIdx.x; chunk < NTOK / 64; chunk += gridDim.x) {
        const int tok0 = chunk * 64, tt = wid & 3, kh = wid >> 2;
        f32x4 acc = {0.f, 0.f, 0.f, 0.f};
        const bf16_t* ap = xn + (size_t)(tok0 + tt * 16 + fr) * 1024 + kh * 512 + 8 * g;
        const bf16_t* bp = wlr + fr * 1024 + kh * 512 + 8 * g;
#pragma unroll
        for (int s = 0; s < 16; ++s) {
            const bf16x8 av = *(const bf16x8*)(ap + s * 32), bv = *(const bf16x8*)(bp + s * 32);
            acc = __builtin_amdgcn_mfma_f32_16x16x32_bf16(av, bv, acc, 0, 0, 0);
        }
#pragma unroll
        for (int i = 0; i < 4; ++i) lrp[(kh * 64 + tt * 16 + 4 * g + i) * 16 + fr] = acc[i] * rowscale(ss1, tok0 + tt * 16 + 4 * g + i);
        __syncthreads();
        { const float s0 = lrp[tid] + lrp[1024 + tid], s1 = lrp[512 + tid] + lrp[1536 + tid]; __syncthreads(); lrp[tid] = s0; lrp[512 + tid] = s1; }
        __syncthreads();
        float cum = 0.f;
        for (int t0 = 0; t0 < 64; t0 += 8) {
            float ls[8];
#pragma unroll
            for (int uu = 0; uu < 8; ++uu) {
                float z = bias;
#pragma unroll
                for (int q = 0; q < 4; ++q) {
                    const f32x4 l0 = *(const LAS f32x4*)(lrp + (t0 + uu) * 16 + q * 4);
#pragma unroll
                    for (int e = 0; e < 4; ++e) z += l0[e] * w2c[q * 4 + e];
                }
                ls[uu] = (fminf(z, 0.f) - __logf(1.0f + __expf(-fabsf(z)))) * (1.0f / 16.0f);
            }
#pragma unroll
            for (int uu = 0; uu < 8; ++uu) {
                cum += ls[uu];
                cumo[(size_t)(tok0 + t0 + uu) * 512 + tid] = (_Float16)(cum * 1.4426950408889634f);
            }
        }
        __syncthreads();
    }
}

constexpr int SC_QP = 0, SC_QM = 17408, SC_KP = 34816, SC_KM = 52224, SC_KT = 69632, SC_SC = 88064, SC_ST = 97280, SC_EL = 101376;
constexpr int SC_KT2 = 0, SC_EL2 = 36864;
constexpr int NSEG = 4, SEGC = 32;
DI float ret_logg(int h) { return (h == 0) ? -0.0317486983145803f : (h == 1) ? -0.015748356968139168f : (h == 2) ? -0.007843177461025893f : -0.003913899321136329f; }

DI void scan_pass1(const Args& a, LAS unsigned char* lds) {
    const int tid = opaque_tid(), lane = tid & 63, w = __builtin_amdgcn_readfirstlane(tid >> 6), fr = lane & 15, g = lane >> 4;
    const int mp = tid >> 4, dseg = tid & 15, m0 = 2 * mp, d0 = 8 * dseg;
    for (int item = blockIdx.x; item < 64 * (NSEG - 1); item += gridDim.x) {
        const int chain = item & 63, seg = item >> 6, X = chain >> 5, b = (chain >> 2) & 7, h = chain & 3;
        const bf16_t* qko = (const bf16_t*)(a.ws + (X ? WS_QKOB : WS_QKOA)) + (size_t)b * SEQ * 1024 + h * 256;
        const bf16_t* vt = (const bf16_t*)(a.ws + (X ? WS_VTB : WS_VTA)) + (size_t)((b * 4 + h) * 256) * SEQ;
        const _Float16* cumg = (const _Float16*)(a.ws + WS_CUM) + (size_t)b * SEQ * 512 + h * 128;
        const float logg = ret_logg(h);
        f32x4 S[8][2];
#pragma unroll
        for (int i = 0; i < 8; ++i) { S[i][0] = (f32x4){0.f, 0.f, 0.f, 0.f}; S[i][1] = (f32x4){0.f, 0.f, 0.f, 0.f}; }
        float dsum[8];
#pragma unroll
        for (int j = 0; j < 8; ++j) dsum[j] = 0.f;
        u32x4 pk0, pk1; u32x4 pc[2], pl; bf16x8 vf[2][2];
        auto load_chunk = [&](int ch) {
            const bf16_t* r0 = qko + (size_t)(ch * 64 + m0) * 1024 + d0 + 128;
            pk0 = *(const u32x4*)r0; pk1 = *(const u32x4*)(r0 + 1024);
            if (X) {
                const _Float16* c0 = cumg + (size_t)(ch * 64 + m0) * 512 + d0;
                pc[0] = *(const u32x4*)c0; pc[1] = *(const u32x4*)(c0 + 512);
                pl = *(const u32x4*)(cumg + (size_t)(ch * 64 + 63) * 512 + d0);
            }
        };
        auto load_vt = [&](int ch) {
#pragma unroll
            for (int vtile = 0; vtile < 2; ++vtile)
#pragma unroll
                for (int ks = 0; ks < 2; ++ks) vf[vtile][ks] = *(const bf16x8*)(vt + ((size_t)ch * 256 + 32 * w + 8 * (fr >> 2) + 4 * vtile + (fr & 3)) * 64 + 32 * ks + 8 * g);
        };
        const int c0 = seg * SEGC;
        load_chunk(c0); load_vt(c0);
        for (int ci = 0; ci < SEGC; ++ci) {
            const int ch = c0 + ci, kto = SC_KT2 + (ci & 1) * 18432, elo = SC_EL2 + (ci & 1) * 512;
            {
                float kt[2][8];
#pragma unroll
                for (int r = 0; r < 2; ++r) {
                    const u32x4 kw = r ? pk1 : pk0;
                    const float kv[8] = {bf_lo(kw.x), bf_hi(kw.x), bf_lo(kw.y), bf_hi(kw.y), bf_lo(kw.z), bf_hi(kw.z), bf_lo(kw.w), bf_hi(kw.w)};
                    if (X) {
#pragma unroll
                        for (int j = 0; j < 8; ++j) kt[r][j] = kv[j] * __builtin_amdgcn_exp2f(h_get(pl, j) - h_get(pc[r], j));
                    } else {
                        const float el = __expf((float)(63 - m0 - r) * logg);
#pragma unroll
                        for (int j = 0; j < 8; ++j) kt[r][j] = kv[j] * el;
                    }
                }
#pragma unroll
                for (int j = 0; j < 8; ++j) {
                    const int d = d0 + j;
                    *(LAS unsigned*)(lds + kto + d * 144 + (((m0 >> 3) ^ ((d >> 4) & 7)) * 16) + (m0 & 7) * 2) = pk_bf16(kt[0][j], kt[1][j]);
                }
                if (X) {
#pragma unroll
                    for (int j = 0; j < 8; ++j) dsum[j] += h_get(pl, j);
                }
                if (mp == 31) {
#pragma unroll
                    for (int j = 0; j < 8; ++j) { *(LAS float*)(lds + elo + (d0 + j) * 4) = X ? __builtin_amdgcn_exp2f(h_get(pl, j)) : __expf(64.0f * logg); }
                }
            }
            __syncthreads();
            load_chunk(ci + 1 < SEGC ? ch + 1 : ch);
#pragma unroll
            for (int dt = 0; dt < 8; ++dt) {
                const f32x4 el = *(const LAS f32x4*)(lds + elo + (16 * dt + 4 * g) * 4);
                S[dt][0] *= el; S[dt][1] *= el;
#pragma unroll
                for (int ks = 0; ks < 2; ++ks) {
                    const bf16x8 ak = *(const LAS bf16x8*)(lds + kto + (16 * dt + fr) * 144 + (((4 * ks + g) ^ (dt & 7)) * 16));
#pragma unroll
                    for (int vtile = 0; vtile < 2; ++vtile) S[dt][vtile] = __builtin_amdgcn_mfma_f32_16x16x32_bf16(ak, vf[vtile][ks], S[dt][vtile], 0, 0, 0);
                }
            }
            load_vt(ci + 1 < SEGC ? ch + 1 : ch);
        }
        float* st = (float*)(a.ws + WS_STATE) + (size_t)(chain * (NSEG - 1) + seg) * 32768;
#pragma unroll
        for (int dt = 0; dt < 8; ++dt)
#pragma unroll
            for (int vtile = 0; vtile < 2; ++vtile) *(f32x4*)(st + ((dt * 2 + vtile) * 512 + tid) * 4) = S[dt][vtile];
        if (mp == 0) {
            float* dg = (float*)(a.ws + WS_DSEG) + (chain * (NSEG - 1) + seg) * 128 + d0;
#pragma unroll
            for (int j = 0; j < 8; ++j) dg[j] = X ? __builtin_amdgcn_exp2f(dsum[j]) : __expf((float)(64 * SEGC) * logg);
        }
        __syncthreads();
    }
}

template <int X> DI void scan_item2(const Args& a, LAS unsigned char* lds, const int chain, const int seg) {
    const int tid = opaque_tid(), lane = tid & 63, w = __builtin_amdgcn_readfirstlane(tid >> 6), fr = lane & 15, g = lane >> 4;
    const int mp = tid >> 4, dseg = tid & 15, m0 = 2 * mp, d0 = 8 * dseg;
    {
        const int b = (chain >> 2) & 7, h = chain & 3;
        bf16_t* qko = (bf16_t*)(a.ws + (X ? WS_QKOB : WS_QKOA)) + (size_t)b * SEQ * 1024 + h * 256;
        const bf16_t* vt = (const bf16_t*)(a.ws + (X ? WS_VTB : WS_VTA)) + (size_t)((b * 4 + h) * 256) * SEQ;
        const _Float16* cumg = (const _Float16*)(a.ws + WS_CUM) + (size_t)b * SEQ * 512 + h * 128;
        const float logg = ret_logg(h);

        f32x4 S[8][2];
#pragma unroll
        for (int i = 0; i < 8; ++i) { S[i][0] = (f32x4){0.f, 0.f, 0.f, 0.f}; S[i][1] = (f32x4){0.f, 0.f, 0.f, 0.f}; }
        for (int j = 0; j < seg; ++j) {
            const float* st = (const float*)(a.ws + WS_STATE) + (size_t)(chain * (NSEG - 1) + j) * 32768;
            const float* dg = (const float*)(a.ws + WS_DSEG) + (chain * (NSEG - 1) + j) * 128;
#pragma unroll
            for (int dt = 0; dt < 8; ++dt) {
                const f32x4 dj = *(const f32x4*)(dg + 16 * dt + 4 * g);
#pragma unroll
                for (int vtile = 0; vtile < 2; ++vtile) S[dt][vtile] = S[dt][vtile] * dj + *(const f32x4*)(st + ((dt * 2 + vtile) * 512 + tid) * 4);
            }
        }

        u32x4 pq0, pq1, pk0, pk1; u32x4 pc[2], pl; bf16x8 vf[2][2];
        auto load_chunk = [&](int ch) {
            const bf16_t* r0 = qko + (size_t)(ch * 64 + m0) * 1024 + d0;
            pq0 = *(const u32x4*)r0; pk0 = *(const u32x4*)(r0 + 128); pq1 = *(const u32x4*)(r0 + 1024); pk1 = *(const u32x4*)(r0 + 1024 + 128);
            if (X) {
                const _Float16* c0 = cumg + (size_t)(ch * 64 + m0) * 512 + d0;
                pc[0] = *(const u32x4*)c0; pc[1] = *(const u32x4*)(c0 + 512);
                pl = *(const u32x4*)(cumg + (size_t)(ch * 64 + 63) * 512 + d0);
            }
        };
        auto load_vt = [&](int ch) {
#pragma unroll
            for (int vtile = 0; vtile < 2; ++vtile)
#pragma unroll
                for (int ks = 0; ks < 2; ++ks) vf[vtile][ks] = *(const bf16x8*)(vt + ((size_t)ch * 256 + 32 * w + 8 * (fr >> 2) + 4 * vtile + (fr & 3)) * 64 + 32 * ks + 8 * g);
        };
        const int cbeg = seg * SEGC, cend = cbeg + SEGC;
        load_chunk(cbeg); load_vt(cbeg);

        for (int ch = cbeg; ch < cend; ++ch) {
            {
                float kt[2][8];
                float elj[8];
                if (X) {
#pragma unroll
                    for (int j = 0; j < 8; ++j) elj[j] = __builtin_amdgcn_exp2f(h_get(pl, j));
                } else {
                    const float e = __expf(64.0f * logg);
#pragma unroll
                    for (int j = 0; j < 8; ++j) elj[j] = e;
                }
#pragma unroll
                for (int r = 0; r < 2; ++r) {
                    const u32x4 qw = r ? pq1 : pq0, kw = r ? pk1 : pk0;
                    const float qv[8] = {bf_lo(qw.x), bf_hi(qw.x), bf_lo(qw.y), bf_hi(qw.y), bf_lo(qw.z), bf_hi(qw.z), bf_lo(qw.w), bf_hi(qw.w)};
                    const float kv[8] = {bf_lo(kw.x), bf_hi(kw.x), bf_lo(kw.y), bf_hi(kw.y), bf_lo(kw.z), bf_hi(kw.z), bf_lo(kw.w), bf_hi(kw.w)};
                    float qp[8], qm[8], kp[8], km[8];
                    if (X) {
#pragma unroll
                        for (int j = 0; j < 8; ++j) {
                            const float ep = __builtin_amdgcn_exp2f(h_get(pc[r], j)), em = __builtin_amdgcn_rcpf(ep);
                            qp[j] = qv[j] * ep; qm[j] = qv[j] * em; kp[j] = kv[j] * ep; km[j] = kv[j] * em; kt[r][j] = km[j] * elj[j];
                        }
                    } else {
                        const float c = (float)(m0 + r + 1) * logg, ep = __expf(c), em = __expf(-c), el = __expf((float)(63 - m0 - r) * logg);
#pragma unroll
                        for (int j = 0; j < 8; ++j) { qp[j] = qv[j] * ep; qm[j] = qv[j] * em; kp[j] = kv[j] * ep; km[j] = kv[j] * em; kt[r][j] = kv[j] * el; }
                    }
                    const int off = (m0 + r) * 272 + dseg * 16;
                    u32x4 o;
                    o.x = pk_bf16(qp[0], qp[1]); o.y = pk_bf16(qp[2], qp[3]); o.z = pk_bf16(qp[4], qp[5]); o.w = pk_bf16(qp[6], qp[7]); *(LAS u32x4*)(lds + SC_QP + off) = o;
                    o.x = pk_bf16(qm[0], qm[1]); o.y = pk_bf16(qm[2], qm[3]); o.z = pk_bf16(qm[4], qm[5]); o.w = pk_bf16(qm[6], qm[7]); *(LAS u32x4*)(lds + SC_QM + off) = o;
                    o.x = pk_bf16(kp[0], kp[1]); o.y = pk_bf16(kp[2], kp[3]); o.z = pk_bf16(kp[4], kp[5]); o.w = pk_bf16(kp[6], kp[7]); *(LAS u32x4*)(lds + SC_KP + off) = o;
                    o.x = pk_bf16(km[0], km[1]); o.y = pk_bf16(km[2], km[3]); o.z = pk_bf16(km[4], km[5]); o.w = pk_bf16(km[6], km[7]); *(LAS u32x4*)(lds + SC_KM + off) = o;
                }
#pragma unroll
                for (int j = 0; j < 8; ++j) {
                    const int d = d0 + j;
                    *(LAS unsigned*)(lds + SC_KT + d * 144 + (((m0 >> 3) ^ ((d >> 4) & 7)) * 16) + (m0 & 7) * 2) = pk_bf16(kt[0][j], kt[1][j]);
                }
                if (mp == 31) {
#pragma unroll
                    for (int j = 0; j < 8; ++j) *(LAS float*)(lds + SC_EL + (d0 + j) * 4) = elj[j];
                }
            }
            __syncthreads();
            load_chunk(ch + 1 < cend ? ch + 1 : ch);
#pragma unroll
            for (int tt = 0; tt < 2; ++tt) {
                const int t = 2 * w + tt, mt = t >> 2, nt = t & 3;
                f32x4 t1 = {0.f, 0.f, 0.f, 0.f}, t2 = {0.f, 0.f, 0.f, 0.f};
                if (nt >= mt) {
#pragma unroll
                    for (int kk = 0; kk < 4; ++kk) {
                        const int ao = (16 * mt + fr) * 272 + (32 * kk + 8 * g) * 2, bo = (16 * nt + fr) * 272 + (32 * kk + 8 * g) * 2;
                        const bf16x8 akm = *(const LAS bf16x8*)(lds + SC_KM + ao), bqp = *(const LAS bf16x8*)(lds + SC_QP + bo);
                        t1 = __builtin_amdgcn_mfma_f32_16x16x32_bf16(akm, bqp, t1, 0, 0, 0);
                    }
                }
                if (nt <= mt) {
#pragma unroll
                    for (int kk = 0; kk < 4; ++kk) {
                        const int ao = (16 * mt + fr) * 272 + (32 * kk + 8 * g) * 2, bo = (16 * nt + fr) * 272 + (32 * kk + 8 * g) * 2;
                        const bf16x8 akp = *(const LAS bf16x8*)(lds + SC_KP + ao), bqm = *(const LAS bf16x8*)(lds + SC_QM + bo);
                        t2 = __builtin_amdgcn_mfma_f32_16x16x32_bf16(akp, bqm, t2, 0, 0, 0);
                    }
                }
                const int n = 16 * nt + fr, mb = 16 * mt + 4 * g;
                float sv[4];
#pragma unroll
                for (int i = 0; i < 4; ++i) sv[i] = (n >= mb + i) ? t1[i] : t2[i];
                u32x2 o; o.x = pk_bf16(sv[0], sv[1]); o.y = pk_bf16(sv[2], sv[3]);
                *(LAS u32x2*)(lds + SC_SC + n * 144 + mb * 2) = o;
            }
            __syncthreads();
            f32x4 oacc[2][4];
#pragma unroll
            for (int vtile = 0; vtile < 2; ++vtile)
#pragma unroll
                for (int nt = 0; nt < 4; ++nt) oacc[vtile][nt] = (f32x4){0.f, 0.f, 0.f, 0.f};
#pragma unroll
            for (int ks = 0; ks < 2; ++ks)
#pragma unroll
                for (int nt = 0; nt < 4; ++nt) {
                    const bf16x8 bs = *(const LAS bf16x8*)(lds + SC_SC + (16 * nt + fr) * 144 + ks * 64 + g * 16);
#pragma unroll
                    for (int vtile = 0; vtile < 2; ++vtile) oacc[vtile][nt] = __builtin_amdgcn_mfma_f32_16x16x32_bf16(vf[vtile][ks], bs, oacc[vtile][nt], 0, 0, 0);
                }
#pragma unroll
            for (int kk = 0; kk < 4; ++kk) {
                bf16x8 sa[2];
#pragma unroll
                for (int vtile = 0; vtile < 2; ++vtile) {
                    const f32x4 s0 = S[2 * kk][vtile], s1 = S[2 * kk + 1][vtile];
                    u32x4 p; p.x = pk_bf16(s0[0], s0[1]); p.y = pk_bf16(s0[2], s0[3]); p.z = pk_bf16(s1[0], s1[1]); p.w = pk_bf16(s1[2], s1[3]);
                    sa[vtile] = __builtin_bit_cast(bf16x8, p);
                }
#pragma unroll
                for (int nt = 0; nt < 4; ++nt) {
                    const int qo = SC_QP + (16 * nt + fr) * 272 + (32 * kk + 4 * g) * 2;
                    const u32x2 lo = *(const LAS u32x2*)(lds + qo), hi = *(const LAS u32x2*)(lds + qo + 32);
                    u32x4 p; p.x = lo.x; p.y = lo.y; p.z = hi.x; p.w = hi.y;
                    const bf16x8 bq = __builtin_bit_cast(bf16x8, p);
#pragma unroll
                    for (int vtile = 0; vtile < 2; ++vtile) oacc[vtile][nt] = __builtin_amdgcn_mfma_f32_16x16x32_bf16(sa[vtile], bq, oacc[vtile][nt], 0, 0, 0);
                }
            }
#pragma unroll
            for (int dt = 0; dt < 8; ++dt) {
                const f32x4 el = *(const LAS f32x4*)(lds + SC_EL + (16 * dt + 4 * g) * 4);
                S[dt][0] *= el; S[dt][1] *= el;
#pragma unroll
                for (int ks = 0; ks < 2; ++ks) {
                    const bf16x8 ak = *(const LAS bf16x8*)(lds + SC_KT + (16 * dt + fr) * 144 + (((4 * ks + g) ^ (dt & 7)) * 16));
#pragma unroll
                    for (int vtile = 0; vtile < 2; ++vtile) S[dt][vtile] = __builtin_amdgcn_mfma_f32_16x16x32_bf16(ak, vf[vtile][ks], S[dt][vtile], 0, 0, 0);
                }
            }
            load_vt(ch + 1 < cend ? ch + 1 : ch);
#pragma unroll
            for (int nt = 0; nt < 4; ++nt) {
                float s = 0.f, q = 0.f;
#pragma unroll
                for (int vtile = 0; vtile < 2; ++vtile)
#pragma unroll
                    for (int i = 0; i < 4; ++i) { const float x = oacc[vtile][nt][i]; s += x; q += x * x; }
                s += __shfl_xor(s, 16); q += __shfl_xor(q, 16); s += __shfl_xor(s, 32); q += __shfl_xor(q, 32);
                if (g == 0) { f32x2 sq = {s, q}; *(LAS f32x2*)(lds + SC_ST + ((16 * nt + fr) * 8 + w) * 8) = sq; }
            }
            __syncthreads();
            f32x4 nw[2];
#pragma unroll
            for (int vtile = 0; vtile < 2; ++vtile) nw[vtile] = X ? *(const f32x4*)(a.in[9] + 32 * w + 8 * g + 4 * vtile) : (f32x4){1.f, 1.f, 1.f, 1.f};
#pragma unroll
            for (int nt = 0; nt < 4; ++nt) {
                const int n = 16 * nt + fr;
                float s = 0.f, q = 0.f;
#pragma unroll
                for (int ww = 0; ww < 4; ++ww) { const f32x4 p = *(const LAS f32x4*)(lds + SC_ST + n * 64 + ww * 16); s += p[0] + p[2]; q += p[1] + p[3]; }
                float mu, rs;
                if (X) { mu = 0.f; rs = rsqrtf(q * (1.0f / 256.0f) + 1e-6f); }
                else { mu = s * (1.0f / 256.0f); const float var = fmaxf(q * (1.0f / 256.0f) - mu * mu, 0.f); rs = rsqrtf(var + 1e-6f); }
                const f32x4 y0 = (oacc[0][nt] - mu) * rs * nw[0], y1 = (oacc[1][nt] - mu) * rs * nw[1];
                u32x4 o; o.x = pk_bf16(y0[0], y0[1]); o.y = pk_bf16(y0[2], y0[3]); o.z = pk_bf16(y1[0], y1[1]); o.w = pk_bf16(y1[2], y1[3]);
                *(u32x4*)(qko + (size_t)(ch * 64 + n) * 1024 + 32 * w + 8 * g) = o;
            }
        }
        __syncthreads();
    }
}
DI void scan_pass2(const Args& a, LAS unsigned char* lds) {
    for (int item = blockIdx.x; item < 64 * NSEG; item += gridDim.x) {
        const int chain = item & 63, seg = item >> 6;
        if (chain >> 5) scan_item2<1>(a, lds, chain, seg); else scan_item2<0>(a, lds, chain, seg);
    }
}

#define XB_TMO      128
#define XB_XCNT(j)  (256  + 64 * (j))
#define XB_XSUB(j)  (1280 + 64 * (j))
#define XB_XGEN(j)  (2304 + 64 * (j))
#define XB_TOP      3328
#define XB_TOPGEN   3392
#define XCD_BAR_WORDS 3456
#define XB_SPIN_CAP (1u << 22)
DI unsigned xb_ld(unsigned* p)              { return __hip_atomic_load(p, __ATOMIC_RELAXED, __HIP_MEMORY_SCOPE_AGENT); }
DI unsigned xb_add(unsigned* p, unsigned v) { return __hip_atomic_fetch_add(p, v, __ATOMIC_RELAXED, __HIP_MEMORY_SCOPE_AGENT); }
DI unsigned xb_xcc_id() { return (unsigned)__builtin_amdgcn_s_getreg((3 << 11) | 20) & 0xFu; }
#define XB_SPIN(cond, bar) do { unsigned _sp = 0; while (cond) { __builtin_amdgcn_s_sleep(1); \
    if ((++_sp & 255u) == 0u) { if (xb_ld(&(bar)[XB_TMO])) break; if (_sp > XB_SPIN_CAP) { atomicAdd(&(bar)[XB_TMO], 1u); break; } } } } while (0)
struct XcdBarrier { unsigned* bar; unsigned x; volatile LAS unsigned* st; };
DI XcdBarrier xcd_barrier_post(unsigned* bar, volatile LAS unsigned* st) {
    XcdBarrier b; b.bar = bar; b.x = xb_xcc_id(); b.st = st;
    if (threadIdx.x == 0) (void)xb_add(&bar[XB_XCNT(b.x)], 1u);
    return b;
}
DI void xcd_barrier_complete(unsigned* bar, unsigned x, unsigned& nloc, unsigned& nx) {
    const unsigned G = gridDim.x * gridDim.y * gridDim.z;
    unsigned sum, cnt, mine, sp = 0u;
    for (;;) {
        sum = 0u; cnt = 0u; mine = 0u;
#pragma unroll
        for (unsigned j = 0; j < 16; ++j) { const unsigned c = xb_ld(&bar[XB_XCNT(j)]); sum += c; cnt += (c > 0u) ? 1u : 0u; mine = (j == x) ? c : mine; }
        if (sum == G) break;
        __builtin_amdgcn_s_sleep(1);
        if ((++sp & 255u) == 0u) { if (xb_ld(&bar[XB_TMO])) break; if (sp > XB_SPIN_CAP) { atomicAdd(&bar[XB_TMO], 1u); break; } }
    }
    nloc = mine > 0u ? mine : 1u; nx = cnt > 0u ? cnt : 1u;
}
DI void xcd_barrier(const XcdBarrier& b) {
    asm volatile("s_waitcnt vmcnt(0)" ::: "memory");
    __syncthreads();
    if (threadIdx.x == 0) {
        unsigned* bar = b.bar;
        __builtin_amdgcn_s_waitcnt(0);
        unsigned nloc = b.st[0], nx = b.st[1];
        if (nloc == 0u) { xcd_barrier_complete(bar, b.x, nloc, nx); b.st[0] = nloc; b.st[1] = nx; }
        const unsigned old = xb_add(&bar[XB_XSUB(b.x)], 1u);
        const unsigned gen = old / nloc;
        if (old + 1u == (gen + 1u) * nloc) {
            __builtin_amdgcn_fence(__ATOMIC_RELEASE, "agent");
            asm volatile("s_waitcnt vmcnt(0)" ::: "memory");
            const unsigned og = xb_add(&bar[XB_TOP], 1u);
            const unsigned tg = og / nx;
            if (og + 1u == (tg + 1u) * nx) xb_add(&bar[XB_TOPGEN], 1u);
            else XB_SPIN(xb_ld(&bar[XB_TOPGEN]) == tg, bar);
            __builtin_amdgcn_fence(__ATOMIC_ACQUIRE, "agent");
            xb_add(&bar[XB_XGEN(b.x)], 1u);
            asm volatile("s_waitcnt vmcnt(0)" ::: "memory");
        } else {
            XB_SPIN(xb_ld(&bar[XB_XGEN(b.x)]) == gen, bar);
            __builtin_amdgcn_fence(__ATOMIC_ACQUIRE, "agent");
            asm volatile("s_waitcnt vmcnt(0)" ::: "memory");
        }
    }
    __syncthreads();
}

__global__ void __launch_bounds__(512, 2) fwd_megakernel(Args a) {
    extern __shared__ __attribute__((aligned(16))) unsigned char shm[];
    LAS unsigned char* lds = (LAS unsigned char*)shm;
    cg::grid_group grid = cg::this_grid();
    unsigned char* ws = a.ws;
    bf16_t* XN = (bf16_t*)(ws + WS_XN);
    bf16_t* G = (bf16_t*)(ws + WS_G);
    bf16_t* QKOA = (bf16_t*)(ws + WS_QKOA); bf16_t* QKOB = (bf16_t*)(ws + WS_QKOB);
    bf16_t* GAB = (bf16_t*)(ws + WS_GAB); bf16_t* MRG = (bf16_t*)(ws + WS_MRG);
    float* SS1 = (float*)(ws + WS_SS1); float* SS2 = (float*)(ws + WS_SS2);

    if (threadIdx.x < 4) ((volatile LAS unsigned*)(lds + 131072))[threadIdx.x] = 0u;
    __syncthreads();
    const XcdBarrier xb = xcd_barrier_post((unsigned*)(ws + WS_BAR), (volatile LAS unsigned*)(lds + 131072));
    wprep_phase(a, lds);
    rmsnorm_phase<true>(a.in[0], a.in[1], XN);
    if (a.ws == nullptr) grid.sync();
    xcd_barrier(xb);
    { EpiSwiGLU<false> e; e.G = G; e.ss = nullptr; run_gemm(lds, XN, (const bf16_t*)(ws + WS_W13_1), NTOK, 5632, 1024, e); }
    xcd_barrier(xb);
    { EpiRes16<true, true, true> e; e.basef = a.in[0]; e.xnb = XN; e.ss = SS1; run_gemm(lds, G, (const bf16_t*)(ws + WS_W2T_1), NTOK, 1024, DFF, e); }
    xcd_barrier(xb);
    { EpiQK e; e.qkoA = QKOA; e.qkoB = QKOB; e.cosT = (const float*)(ws + WS_ROTC); e.sinT = (const float*)(ws + WS_ROTS); e.ss = SS1; run_gemm(lds, XN, (const bf16_t*)(ws + WS_WQK), NTOK, 2048, 1024, e); }
    { EpiVT e; e.vtA = (bf16_t*)(ws + WS_VTA); e.vtB = (bf16_t*)(ws + WS_VTB); e.ss = SS1; run_gemm(lds, (const bf16_t*)(ws + WS_WV), XN, 2048, NTOK, 1024, e); }
    cum_phase(a, lds);
    xcd_barrier(xb);
    scan_pass1(a, lds);
    {
        const int nit = 64 * (NSEG - 1), G = (int)gridDim.x;
        if (G > nit) { if ((int)blockIdx.x >= nit) wprep_jobs<1>(a, lds, G - nit, (int)blockIdx.x - nit); }
        else wprep_jobs<1>(a, lds, G, (int)blockIdx.x);
    }
    xcd_barrier(xb);
    scan_pass2(a, lds);
    xcd_barrier(xb);
    { EpiRGate e0; e0.oA = QKOA; e0.oB = QKOB; e0.ss = SS1; EpiGates e1; e1.gab = GAB; e1.ss = SS1;
      run_gemm_dual(lds, XN, (const bf16_t*)(ws + WS_WRG), XN, (const bf16_t*)(ws + WS_WRG + 4 * SZ_1K / 2), NTOK, 2048, 1024, e0, e1); }
    xcd_barrier(xb);
    { EpiMerge<0> e0; e0.gab = GAB; e0.mrg = MRG; EpiMerge<1> e1; e1.gab = GAB; e1.mrg = MRG;
      run_gemm_dual(lds, QKOA, (const bf16_t*)(ws + WS_WBR), QKOB, (const bf16_t*)(ws + WS_WBG), NTOK, 1024, 1024, e0, e1); }
    xcd_barrier(xb);
    { EpiRes16<true, false, false> e; e.basef = nullptr; e.xnb = XN; e.ss = SS2; run_gemm(lds, MRG, (const bf16_t*)(ws + WS_WOUT), NTOK, 1024, 1024, e); }
    xcd_barrier(xb);
    { EpiSwiGLU<true> e; e.G = G; e.ss = SS2; run_gemm(lds, XN, (const bf16_t*)(ws + WS_W13_2), NTOK, 5632, 1024, e); }
    xcd_barrier(xb);
    { EpiRes16<false, true, false> e; e.basef = nullptr; e.xnb = XN; e.ss = nullptr; run_gemm(lds, G, (const bf16_t*)(ws + WS_W2T_2), NTOK, 1024, DFF, e); }
    xcd_barrier(xb);
    final_norm_phase(XN, a.in[17], a.out);
}

extern "C" void kernel_launch(void* const* d_in, const int* in_sizes, int n_in, void* d_out, int out_size, void* d_ws, size_t ws_size, hipStream_t stream) {
    static int grid_blocks = 0;
    if (grid_blocks == 0) {
        if (n_in != 18 || ws_size < WS_END) { fprintf(stderr, "kernel_launch: unexpected n_in %d / ws_size %zu (need %zu)\n", n_in, ws_size, (size_t)WS_END); grid_blocks = -1; return; }
        int dev = 0, cus = 0, per_cu = 0;
        hipGetDevice(&dev);
        hipDeviceGetAttribute(&cus, hipDeviceAttributeMultiprocessorCount, dev);
        if (hipFuncSetAttribute((const void*)fwd_megakernel, hipFuncAttributeMaxDynamicSharedMemorySize, LDS_BYTES) != hipSuccess) { fprintf(stderr, "kernel_launch: hipFuncSetAttribute failed\n"); grid_blocks = -1; return; }
        if (hipOccupancyMaxActiveBlocksPerMultiprocessor(&per_cu, (const void*)fwd_megakernel, 512, LDS_BYTES) != hipSuccess || per_cu < 1) { fprintf(stderr, "kernel_launch: occupancy query says %d\n", per_cu); per_cu = 1; }
        (void)hipGetLastError();
        grid_blocks = cus * per_cu;
    }
    if (grid_blocks < 0) return;
    if (hipMemsetAsync((char*)d_ws + WS_BAR, 0, 16384, stream) != hipSuccess) { fprintf(stderr, "kernel_launch: memset of the barrier words failed\n"); return; }
    Args a{};
    for (int i = 0; i < 18; ++i) a.in[i] = (const float*)d_in[i];
    a.out = (float*)d_out; a.ws = (unsigned char*)d_ws;
    void* args[] = {&a};
    hipError_t e = hipLaunchCooperativeKernel((const void*)fwd_megakernel, dim3(grid_blocks), dim3(512), args, LDS_BYTES, stream);
    if (e != hipSuccess) fprintf(stderr, "cooperative launch failed: %s (grid %d)\n", hipGetErrorString(e), grid_blocks);
}
```

```cpp
#include <hip/hip_runtime.h>
#include <hip/hip_cooperative_groups.h>
#include <cstdio>
namespace cg = cooperative_groups;

#define LAS __attribute__((address_space(3)))
#define DI __device__ __forceinline__
typedef unsigned short bf16_t;
typedef short bf16x8 __attribute__((ext_vector_type(8)));
typedef float f32x4 __attribute__((ext_vector_type(4)));
typedef float f32x2 __attribute__((ext_vector_type(2)));
typedef unsigned u32x4 __attribute__((ext_vector_type(4)));
typedef unsigned u32x2 __attribute__((ext_vector_type(2)));
typedef __bf16 bf16v2 __attribute__((ext_vector_type(2)));

constexpr int NTOK = 65536, DM = 1024, DFF = 2816, SEQ = 8192, DIN = 8208;
constexpr int LDS_BYTES = 131072 + 16;

constexpr size_t SZ_W13 = (size_t)5632 * 1024 * 2, SZ_W2T = (size_t)1024 * 2816 * 2, SZ_1K = (size_t)1024 * 1024 * 2;
constexpr size_t WS_W13_1 = 0;
constexpr size_t WS_W2T_1 = WS_W13_1 + SZ_W13;
constexpr size_t WS_W13_2 = WS_W2T_1 + SZ_W2T;
constexpr size_t WS_W2T_2 = WS_W13_2 + SZ_W13;
constexpr size_t WS_WQK = WS_W2T_2 + SZ_W2T;
constexpr size_t WS_WV = WS_WQK + 2 * SZ_1K;
constexpr size_t WS_WRG = WS_WV + 2 * SZ_1K;
constexpr size_t WS_WBR = WS_WRG + 4 * SZ_1K;
constexpr size_t WS_WBG = WS_WBR + SZ_1K;
constexpr size_t WS_WOUT = WS_WBG + SZ_1K;
constexpr size_t WS_WLR = WS_WOUT + SZ_1K;
constexpr size_t WS_ROTC = WS_WLR + 32768;
constexpr size_t WS_ROTS = WS_ROTC + (size_t)8192 * 64 * 4;
constexpr size_t WS_XN = WS_ROTS + (size_t)8192 * 64 * 4;
constexpr size_t SZ_ACT = (size_t)NTOK * 1024 * 2;
constexpr size_t WS_BIG = WS_XN + SZ_ACT;
constexpr size_t WS_G = WS_BIG;
constexpr size_t WS_QKOA = WS_BIG;
constexpr size_t WS_QKOB = WS_QKOA + SZ_ACT;
constexpr size_t WS_VTA = WS_QKOB + SZ_ACT;
constexpr size_t WS_VTB = WS_VTA + SZ_ACT;
constexpr size_t WS_GAB = WS_VTA;
constexpr size_t WS_CUM = WS_VTB + SZ_ACT;
constexpr size_t WS_MRG = WS_CUM;
constexpr size_t WS_BAR = WS_CUM + (size_t)NTOK * 512 * 4;
constexpr size_t WS_STATE = WS_BAR + 16384;
constexpr size_t WS_DSEG = WS_STATE + (size_t)64 * 3 * 32768 * 4;
constexpr size_t WS_SS1 = WS_DSEG + 64 * 3 * 128 * 4;
constexpr size_t WS_SS2 = WS_SS1 + (size_t)NTOK * 4;
constexpr size_t WS_END = WS_SS2 + (size_t)NTOK * 4;

struct Args {
    const float* in[18];
    float* out;
    unsigned char* ws;
};

DI unsigned pk_bf16(float lo, float hi) { f32x2 v = {lo, hi}; return __builtin_bit_cast(unsigned, __builtin_convertvector(v, bf16v2)); }
DI float bf_lo(unsigned w) { return __uint_as_float(w << 16); }
DI float bf_hi(unsigned w) { return __uint_as_float(w & 0xffff0000u); }
DI int opaque_tid() { int t = threadIdx.x; asm volatile("" : "+v"(t)); return t; }
DI float rowscale(const float* ss, int row) { return rsqrtf(ss[row] * (1.0f / 1024.0f) + 1e-6f); }
struct RowScales { float r[2][4]; };
DI RowScales load_rowscales(const float* ss, int row0) {
    RowScales t;
#pragma unroll
    for (int ai = 0; ai < 2; ++ai)
#pragma unroll
        for (int m = 0; m < 4; ++m) t.r[ai][m] = ss[row0 + ai * 128 + m * 16];
#pragma unroll
    for (int ai = 0; ai < 2; ++ai)
#pragma unroll
        for (int m = 0; m < 4; ++m) t.r[ai][m] = rsqrtf(t.r[ai][m] * (1.0f / 1024.0f) + 1e-6f);
    return t;
}
DI float h_get(u32x4 w, int j) { return (float)__builtin_bit_cast(_Float16, (unsigned short)(w[j >> 1] >> (16 * (j & 1)))); }
DI f32x4 bf_lo4(u32x4 w) { f32x4 r; r[0] = bf_lo(w.x); r[1] = bf_hi(w.x); r[2] = bf_lo(w.y); r[3] = bf_hi(w.y); return r; }
DI f32x4 bf_hi4(u32x4 w) { f32x4 r; r[0] = bf_lo(w.z); r[1] = bf_hi(w.z); r[2] = bf_lo(w.w); r[3] = bf_hi(w.w); return r; }
DI float fast_sigmoid(float x) { return __builtin_amdgcn_rcpf(1.0f + __expf(-x)); }
DI float fast_silu(float x) { return x * fast_sigmoid(x); }

namespace pg8 {
constexpr int BM = 256, BK = 64, HALF = 128, HTB = HALF * BK * 2, STAGE_BYTES = 8 * HTB, NXCD = 8, WGM = 8;
DI int lds_byte(int r, int c) { const int st = (r >> 4) * 2 + (c >> 5), rr = r & 15, cc = c & 31, ob = rr * 64 + cc * 2; return st * 1024 + (ob ^ (((ob >> 9) & 1) << 5)); }
DI void stage_rc(int b, int& R, int& C) { const int st = b / 1024, sb = b % 1024, swz = sb ^ (((sb >> 9) & 1) << 5); R = (st >> 1) * 16 + swz / 64; C = (st & 1) * 32 + (swz % 64) / 2; }
DI int perm32(int rho) { const int n = rho >> 4, i = rho & 15; return 8 * (i >> 2) + 4 * n + (i & 3); }
struct Unit { int pm, pn; };
struct Gemm { const bf16_t* A; const bf16_t* Bt; int M, N, K; };
struct StaticOrder {
    int nM, nN, nwg, G, c;
    DI void init(int M, int N, int G_, int c_) { nM = M / BM; nN = N / BM; nwg = nM * nN; G = G_; c = c_; }
    DI bool next(int i, Unit& u) const {
        const long L = (long)i * G + c; if (L >= nwg) return false;
        int wgid = (int)L; { const int q = nwg / NXCD, r = nwg % NXCD, xcd = wgid % NXCD, off = wgid / NXCD; wgid = (xcd < r ? xcd * (q + 1) : r * (q + 1) + (xcd - r) * q) + off; }
        const int nig = WGM * nN, gid = wgid / nig, fm = gid * WGM, gsz = (nM - fm) < WGM ? (nM - fm) : WGM;
        u.pm = fm + ((wgid % nig) % gsz); u.pn = (wgid % nig) / gsz; return true;
    }
};

template <class Epi>
DI void gemm_phase(LAS unsigned char* lds, const Gemm g, const StaticOrder S, const Epi E) {
    const int tid = opaque_tid(), wid = __builtin_amdgcn_readfirstlane(tid >> 6), lane = tid & 63, wr = wid >> 2, wc = wid & 3, fr = lane & 15, fq = lane >> 4;
    const int K = g.K, nt = K / BK;
    unsigned voffA[2], voffB[2];
#pragma unroll
    for (int i = 0; i < 2; ++i) { int R, C; stage_rc(tid * 16 + i * 8192, R, C); const int Rb = (R & ~31) + perm32(R & 31);
        voffA[i] = (unsigned)(R * K + C) * 2u; voffB[i] = (unsigned)(Rb * K + C) * 2u; }
    const size_t kstep = (size_t)(BK * 2);
    const size_t hstep = (size_t)HALF * K * 2;
    const size_t tstep = 2 * hstep;
    const unsigned ldsw = (unsigned)wid * 1024u;
    const int aoff = lds_byte(wr * 64 + fr, fq * 8), boff = lds_byte(wc * 32 + fr, fq * 8);
#define PG8_SA(b, h) (((b) * 2 + (h)) * HTB)
#define PG8_SB(b, h) ((4 + (b) * 2 + (h)) * HTB)
#define PG8_STAGE(bufoff, gbase, voff) do { _Pragma("unroll") for (int _i = 0; _i < 2; ++_i) \
        __builtin_amdgcn_global_load_lds((const unsigned*)((const char*)(gbase) + (voff)[_i]), (LAS unsigned*)(lds + (bufoff) + ldsw + _i * 8192), 16, 0, 0); } while (0)
#define PG8_LDA(dst, b, h) do { _Pragma("unroll") for (int m = 0; m < 4; ++m) _Pragma("unroll") for (int k = 0; k < 2; ++k) dst[m][k] = *(const LAS bf16x8*)(lds + PG8_SA(b, h) + aoff + m * 2048 + k * 1024); } while (0)
#define PG8_LDB(dst, b, h) do { _Pragma("unroll") for (int n = 0; n < 2; ++n) _Pragma("unroll") for (int k = 0; k < 2; ++k) dst[n][k] = *(const LAS bf16x8*)(lds + PG8_SB(b, h) + boff + n * 2048 + k * 1024); } while (0)
#define PG8_MMA(ai, bj, At, Bt) do { __builtin_amdgcn_s_setprio(1); _Pragma("unroll") for (int m = 0; m < 4; ++m) _Pragma("unroll") for (int n = 0; n < 2; ++n) _Pragma("unroll") for (int k = 0; k < 2; ++k) \
        acc[ai][bj][m][n] = __builtin_amdgcn_mfma_f32_16x16x32_bf16(Bt[n][k], At[m][k], acc[ai][bj][m][n], 0, 0, 0); __builtin_amdgcn_s_setprio(0); } while (0)
#define PG8_WAIT_V(n) asm volatile("s_waitcnt vmcnt(" #n ")" ::: "memory")
#define PG8_WAIT_L(n) asm volatile("s_waitcnt lgkmcnt(" #n ")" ::: "memory")
#define PG8_BAR __builtin_amdgcn_s_barrier()
#define PG8_SCHED __builtin_amdgcn_sched_barrier(0)
    Unit cur, nxt; int ui = 0;
    if (!S.next(0, cur)) return;
    f32x4 acc[2][2][4][2];
#pragma unroll
    for (int a = 0; a < 2; ++a)
#pragma unroll
        for (int b = 0; b < 2; ++b)
#pragma unroll
            for (int m = 0; m < 4; ++m)
#pragma unroll
                for (int n = 0; n < 2; ++n) acc[a][b][m][n] = (f32x4){0.f, 0.f, 0.f, 0.f};
    bf16x8 At[4][2], B0[2][2], B1[2][2];
    const char* cA = (const char*)g.A + (size_t)cur.pm * tstep; const char* cB = (const char*)g.Bt + (size_t)cur.pn * tstep;
    PG8_STAGE(PG8_SB(0, 0), cB, voffB); PG8_STAGE(PG8_SA(0, 0), cA, voffA); PG8_STAGE(PG8_SB(0, 1), cB + hstep, voffB); PG8_STAGE(PG8_SA(0, 1), cA + hstep, voffA);
    if (wr == 1) PG8_BAR;
    PG8_WAIT_V(4); PG8_BAR;
    PG8_STAGE(PG8_SB(1, 0), cB + kstep, voffB); PG8_STAGE(PG8_SA(1, 0), cA + kstep, voffA); PG8_STAGE(PG8_SB(1, 1), cB + hstep + kstep, voffB);
    PG8_WAIT_V(6); PG8_BAR;
    for (;;) {
        const bool has_next = S.next(ui + 1, nxt);
        const char* nA = has_next ? (const char*)g.A + (size_t)nxt.pm * tstep : cA; const char* nB = has_next ? (const char*)g.Bt + (size_t)nxt.pn * tstep : cB;
        for (int t = 0; t < nt; t += 2) {
            const bool last = (t == nt - 2);
            const char* a1 = cA + (size_t)(t + 1) * kstep;
            const char* a2 = last ? nA : cA + (size_t)(t + 2) * kstep; const char* b2 = last ? nB : cB + (size_t)(t + 2) * kstep;
            const char* a3 = a2 + kstep; const char* b3 = b2 + kstep;
            PG8_LDB(B0, 0, 0); PG8_SCHED; PG8_LDA(At, 0, 0); PG8_STAGE(PG8_SA(1, 1), a1 + hstep, voffA);
            PG8_WAIT_L(8); PG8_BAR; PG8_WAIT_L(0); PG8_MMA(0, 0, At, B0); PG8_BAR; PG8_SCHED;
            PG8_LDB(B1, 0, 1); PG8_STAGE(PG8_SB(0, 0), b2, voffB);
            PG8_BAR; PG8_WAIT_L(0); PG8_MMA(0, 1, At, B1); PG8_BAR;
            PG8_LDA(At, 0, 1); PG8_STAGE(PG8_SA(0, 0), a2, voffA);
            PG8_BAR; PG8_WAIT_L(0); PG8_MMA(1, 0, At, B0); PG8_BAR; PG8_SCHED;
            PG8_STAGE(PG8_SB(0, 1), b2 + hstep, voffB);
            PG8_WAIT_V(6); PG8_BAR; PG8_MMA(1, 1, At, B1); PG8_BAR;
            PG8_LDB(B0, 1, 0); PG8_SCHED; PG8_LDA(At, 1, 0); PG8_STAGE(PG8_SA(0, 1), a2 + hstep, voffA);
            PG8_WAIT_L(8); PG8_BAR; PG8_WAIT_L(0); PG8_MMA(0, 0, At, B0); PG8_BAR; PG8_SCHED;
            PG8_LDB(B1, 1, 1); PG8_STAGE(PG8_SB(1, 0), b3, voffB);
            PG8_BAR; PG8_WAIT_L(0); PG8_MMA(0, 1, At, B1); PG8_BAR;
            PG8_LDA(At, 1, 1); PG8_STAGE(PG8_SA(1, 0), a3, voffA);
            PG8_BAR; PG8_WAIT_L(0); PG8_MMA(1, 0, At, B0); PG8_BAR; PG8_SCHED;
            PG8_STAGE(PG8_SB(1, 1), b3 + hstep, voffB);
            PG8_WAIT_V(6); PG8_BAR; PG8_MMA(1, 1, At, B1); PG8_BAR;
        }
        E(acc, cur, wr, wc, fr, fq);
        if (!has_next) break;
#pragma unroll
        for (int a = 0; a < 2; ++a)
#pragma unroll
            for (int b = 0; b < 2; ++b)
#pragma unroll
                for (int m = 0; m < 4; ++m)
#pragma unroll
                    for (int n = 0; n < 2; ++n) acc[a][b][m][n] = (f32x4){0.f, 0.f, 0.f, 0.f};
        cur = nxt; cA = nA; cB = nB; ++ui;
    }
    PG8_WAIT_V(0);
    if (wr == 0) PG8_BAR;
    PG8_BAR;
#undef PG8_SA
#undef PG8_SB
#undef PG8_STAGE
#undef PG8_LDA
#undef PG8_LDB
#undef PG8_MMA
#undef PG8_WAIT_V
#undef PG8_WAIT_L
#undef PG8_BAR
#undef PG8_SCHED
}
template <class Epi0, class Epi1>
DI void gemm_phase_dual(LAS unsigned char* lds, const Gemm g, const Gemm g1, const StaticOrder S, const StaticOrder S1, const Epi0 E0, const Epi1 E1) {
    const int tid = opaque_tid(), wid = __builtin_amdgcn_readfirstlane(tid >> 6), lane = tid & 63, wr = wid >> 2, wc = wid & 3, fr = lane & 15, fq = lane >> 4;
    const int K = g.K, nt = K / BK;
    unsigned voffA[2], voffB[2];
#pragma unroll
    for (int i = 0; i < 2; ++i) { int R, C; stage_rc(tid * 16 + i * 8192, R, C); const int Rb = (R & ~31) + perm32(R & 31);
        voffA[i] = (unsigned)(R * K + C) * 2u; voffB[i] = (unsigned)(Rb * K + C) * 2u; }
    const size_t kstep = (size_t)(BK * 2);
    const size_t hstep = (size_t)HALF * K * 2;
    const size_t tstep = 2 * hstep;
    const unsigned ldsw = (unsigned)wid * 1024u;
    const int aoff = lds_byte(wr * 64 + fr, fq * 8), boff = lds_byte(wc * 32 + fr, fq * 8);
#define PG8_SA(b, h) (((b) * 2 + (h)) * HTB)
#define PG8_SB(b, h) ((4 + (b) * 2 + (h)) * HTB)
#define PG8_STAGE(bufoff, gbase, voff) do { _Pragma("unroll") for (int _i = 0; _i < 2; ++_i) \
        __builtin_amdgcn_global_load_lds((const unsigned*)((const char*)(gbase) + (voff)[_i]), (LAS unsigned*)(lds + (bufoff) + ldsw + _i * 8192), 16, 0, 0); } while (0)
#define PG8_LDA(dst, b, h) do { _Pragma("unroll") for (int m = 0; m < 4; ++m) _Pragma("unroll") for (int k = 0; k < 2; ++k) dst[m][k] = *(const LAS bf16x8*)(lds + PG8_SA(b, h) + aoff + m * 2048 + k * 1024); } while (0)
#define PG8_LDB(dst, b, h) do { _Pragma("unroll") for (int n = 0; n < 2; ++n) _Pragma("unroll") for (int k = 0; k < 2; ++k) dst[n][k] = *(const LAS bf16x8*)(lds + PG8_SB(b, h) + boff + n * 2048 + k * 1024); } while (0)
#define PG8_MMA(ai, bj, At, Bt) do { __builtin_amdgcn_s_setprio(1); _Pragma("unroll") for (int m = 0; m < 4; ++m) _Pragma("unroll") for (int n = 0; n < 2; ++n) _Pragma("unroll") for (int k = 0; k < 2; ++k) \
        acc[ai][bj][m][n] = __builtin_amdgcn_mfma_f32_16x16x32_bf16(Bt[n][k], At[m][k], acc[ai][bj][m][n], 0, 0, 0); __builtin_amdgcn_s_setprio(0); } while (0)
#define PG8_WAIT_V(n) asm volatile("s_waitcnt vmcnt(" #n ")" ::: "memory")
#define PG8_WAIT_L(n) asm volatile("s_waitcnt lgkmcnt(" #n ")" ::: "memory")
#define PG8_BAR __builtin_amdgcn_s_barrier()
#define PG8_SCHED __builtin_amdgcn_sched_barrier(0)
    Unit cur, nxt; int ui = 0;
    if (!S.next(0, cur)) return;
    f32x4 acc[2][2][4][2];
#pragma unroll
    for (int a = 0; a < 2; ++a)
#pragma unroll
        for (int b = 0; b < 2; ++b)
#pragma unroll
            for (int m = 0; m < 4; ++m)
#pragma unroll
                for (int n = 0; n < 2; ++n) acc[a][b][m][n] = (f32x4){0.f, 0.f, 0.f, 0.f};
    bf16x8 At[4][2], B0[2][2], B1[2][2];
    const char* cA = (const char*)g.A + (size_t)cur.pm * tstep; const char* cB = (const char*)g.Bt + (size_t)cur.pn * tstep;
    PG8_STAGE(PG8_SB(0, 0), cB, voffB); PG8_STAGE(PG8_SA(0, 0), cA, voffA); PG8_STAGE(PG8_SB(0, 1), cB + hstep, voffB); PG8_STAGE(PG8_SA(0, 1), cA + hstep, voffA);
    if (wr == 1) PG8_BAR;
    PG8_WAIT_V(4); PG8_BAR;
    PG8_STAGE(PG8_SB(1, 0), cB + kstep, voffB); PG8_STAGE(PG8_SA(1, 0), cA + kstep, voffA); PG8_STAGE(PG8_SB(1, 1), cB + hstep + kstep, voffB);
    PG8_WAIT_V(6); PG8_BAR;
    for (;;) {
        const int nj = (ui + 1) & 1;
        const bool has_next = nj ? S1.next((ui + 1) >> 1, nxt) : S.next((ui + 1) >> 1, nxt);
        const char* nAb = nj ? (const char*)g1.A : (const char*)g.A; const char* nBb = nj ? (const char*)g1.Bt : (const char*)g.Bt;
        const char* nA = has_next ? nAb + (size_t)nxt.pm * tstep : cA; const char* nB = has_next ? nBb + (size_t)nxt.pn * tstep : cB;
        for (int t = 0; t < nt; t += 2) {
            const bool last = (t == nt - 2);
            const char* a1 = cA + (size_t)(t + 1) * kstep;
            const char* a2 = last ? nA : cA + (size_t)(t + 2) * kstep; const char* b2 = last ? nB : cB + (size_t)(t + 2) * kstep;
            const char* a3 = a2 + kstep; const char* b3 = b2 + kstep;
            PG8_LDB(B0, 0, 0); PG8_SCHED; PG8_LDA(At, 0, 0); PG8_STAGE(PG8_SA(1, 1), a1 + hstep, voffA);
            PG8_WAIT_L(8); PG8_BAR; PG8_WAIT_L(0); PG8_MMA(0, 0, At, B0); PG8_BAR; PG8_SCHED;
            PG8_LDB(B1, 0, 1); PG8_STAGE(PG8_SB(0, 0), b2, voffB);
            PG8_BAR; PG8_WAIT_L(0); PG8_MMA(0, 1, At, B1); PG8_BAR;
            PG8_LDA(At, 0, 1); PG8_STAGE(PG8_SA(0, 0), a2, voffA);
            PG8_BAR; PG8_WAIT_L(0); PG8_MMA(1, 0, At, B0); PG8_BAR; PG8_SCHED;
            PG8_STAGE(PG8_SB(0, 1), b2 + hstep, voffB);
            PG8_WAIT_V(6); PG8_BAR; PG8_MMA(1, 1, At, B1); PG8_BAR;
            PG8_LDB(B0, 1, 0); PG8_SCHED; PG8_LDA(At, 1, 0); PG8_STAGE(PG8_SA(0, 1), a2 + hstep, voffA);
            PG8_WAIT_L(8); PG8_BAR; PG8_WAIT_L(0); PG8_MMA(0, 0, At, B0); PG8_BAR; PG8_SCHED;
            PG8_LDB(B1, 1, 1); PG8_STAGE(PG8_SB(1, 0), b3, voffB);
            PG8_BAR; PG8_WAIT_L(0); PG8_MMA(0, 1, At, B1); PG8_BAR;
            PG8_LDA(At, 1, 1); PG8_STAGE(PG8_SA(1, 0), a3, voffA);
            PG8_BAR; PG8_WAIT_L(0); PG8_MMA(1, 0, At, B0); PG8_BAR; PG8_SCHED;
            PG8_STAGE(PG8_SB(1, 1), b3 + hstep, voffB);
            PG8_WAIT_V(6); PG8_BAR; PG8_MMA(1, 1, At, B1); PG8_BAR;
        }
        if (ui & 1) E1(acc, cur, wr, wc, fr, fq); else E0(acc, cur, wr, wc, fr, fq);
        if (!has_next) break;
#pragma unroll
        for (int a = 0; a < 2; ++a)
#pragma unroll
            for (int b = 0; b < 2; ++b)
#pragma unroll
                for (int m = 0; m < 4; ++m)
#pragma unroll
                    for (int n = 0; n < 2; ++n) acc[a][b][m][n] = (f32x4){0.f, 0.f, 0.f, 0.f};
        cur = nxt; cA = nA; cB = nB; ++ui;
    }
    PG8_WAIT_V(0);
    if (wr == 0) PG8_BAR;
    PG8_BAR;
#undef PG8_SA
#undef PG8_SB
#undef PG8_STAGE
#undef PG8_LDA
#undef PG8_LDB
#undef PG8_MMA
#undef PG8_WAIT_V
#undef PG8_WAIT_L
#undef PG8_BAR
#undef PG8_SCHED
}
}
using pg8::Unit;
typedef const f32x4 (&AccRef)[2][2][4][2];

template <bool RS> struct EpiSwiGLU {
    bf16_t* G; const float* ss;
    DI void operator()(AccRef acc, const Unit& u, int wr, int wc, int fr, int fq) const {
        const int row0 = u.pm * 256 + wr * 64 + fr, col = u.pn * 128 + wc * 32 + 8 * fq;
        RowScales rsc; if (RS) rsc = load_rowscales(ss, row0);
#pragma unroll
        for (int ai = 0; ai < 2; ++ai)
#pragma unroll
            for (int m = 0; m < 4; ++m) {
                const int row = row0 + ai * 128 + m * 16;
                const float r = RS ? rsc.r[ai][m] : 1.0f;
                const f32x4 a0 = acc[ai][0][m][0] * r, a1 = acc[ai][0][m][1] * r, b0 = acc[ai][1][m][0] * r, b1 = acc[ai][1][m][1] * r;
                u32x4 w;
                w.x = pk_bf16(fast_silu(a0[0]) * b0[0], fast_silu(a0[1]) * b0[1]); w.y = pk_bf16(fast_silu(a0[2]) * b0[2], fast_silu(a0[3]) * b0[3]);
                w.z = pk_bf16(fast_silu(a1[0]) * b1[0], fast_silu(a1[1]) * b1[1]); w.w = pk_bf16(fast_silu(a1[2]) * b1[2], fast_silu(a1[3]) * b1[3]);
                *(u32x4*)(G + (size_t)row * DFF + col) = w;
            }
    }
};
template <bool STATS, bool HALFSTEP> struct EpiRes {
    const float* base; float* out; bf16_t* xnb; float* ss;
    DI void operator()(AccRef acc, const Unit& u, int wr, int wc, int fr, int fq) const {
        const float scale = HALFSTEP ? 0.5f : 1.0f;
        const int row0 = u.pm * 256 + wr * 64 + fr, col0 = u.pn * 256 + wc * 32 + 8 * fq;
#pragma unroll
        for (int ai = 0; ai < 2; ++ai) {
            f32x4 bv[4][2][2];
#pragma unroll
            for (int m = 0; m < 4; ++m)
#pragma unroll
                for (int bj = 0; bj < 2; ++bj) {
                    const size_t o = (size_t)(row0 + ai * 128 + m * 16) * DM + col0 + bj * 128;
                    bv[m][bj][0] = *(const f32x4*)(base + o); bv[m][bj][1] = *(const f32x4*)(base + o + 4);
                }
#pragma unroll
            for (int m = 0; m < 4; ++m) {
                const int row = row0 + ai * 128 + m * 16;
                float q = 0.f;
#pragma unroll
                for (int bj = 0; bj < 2; ++bj) {
                    const size_t o = (size_t)row * DM + col0 + bj * 128;
                    const f32x4 r0 = bv[m][bj][0] + scale * acc[ai][bj][m][0], r1 = bv[m][bj][1] + scale * acc[ai][bj][m][1];
                    *(f32x4*)(out + o) = r0;
                    *(f32x4*)(out + o + 4) = r1;
                    if (STATS) {
                        u32x4 w; w.x = pk_bf16(r0[0], r0[1]); w.y = pk_bf16(r0[2], r0[3]); w.z = pk_bf16(r1[0], r1[1]); w.w = pk_bf16(r1[2], r1[3]);
                        *(u32x4*)(xnb + o) = w;
                        q += r0[0] * r0[0] + r0[1] * r0[1] + r0[2] * r0[2] + r0[3] * r0[3] + r1[0] * r1[0] + r1[1] * r1[1] + r1[2] * r1[2] + r1[3] * r1[3];
                    }
                }
                if (STATS) { q += __shfl_xor(q, 16); q += __shfl_xor(q, 32); if (fq == 0) atomicAdd(ss + row, q); }
            }
        }
    }
};
template <bool STATS, bool HALFSTEP, bool BASEF32> struct EpiRes16 {
    const float* basef; bf16_t* xnb; float* ss;
    DI void operator()(AccRef acc, const Unit& u, int wr, int wc, int fr, int fq) const {
        const float scale = HALFSTEP ? 0.5f : 1.0f;
        const int row0 = u.pm * 256 + wr * 64 + fr, col0 = u.pn * 256 + wc * 32 + 8 * fq;
#pragma unroll
        for (int ai = 0; ai < 2; ++ai) {
            f32x4 bv[4][2][2];
#pragma unroll
            for (int m = 0; m < 4; ++m)
#pragma unroll
                for (int bj = 0; bj < 2; ++bj) {
                    const size_t o = (size_t)(row0 + ai * 128 + m * 16) * DM + col0 + bj * 128;
                    if (BASEF32) { bv[m][bj][0] = *(const f32x4*)(basef + o); bv[m][bj][1] = *(const f32x4*)(basef + o + 4); }
                    else { const u32x4 h = *(const u32x4*)(xnb + o); bv[m][bj][0] = bf_lo4(h); bv[m][bj][1] = bf_hi4(h); }
                }
#pragma unroll
            for (int m = 0; m < 4; ++m) {
                const int row = row0 + ai * 128 + m * 16;
                float q = 0.f;
#pragma unroll
                for (int bj = 0; bj < 2; ++bj) {
                    const size_t o = (size_t)row * DM + col0 + bj * 128;
                    const f32x4 r0 = bv[m][bj][0] + scale * acc[ai][bj][m][0], r1 = bv[m][bj][1] + scale * acc[ai][bj][m][1];
                    u32x4 w; w.x = pk_bf16(r0[0], r0[1]); w.y = pk_bf16(r0[2], r0[3]); w.z = pk_bf16(r1[0], r1[1]); w.w = pk_bf16(r1[2], r1[3]);
                    *(u32x4*)(xnb + o) = w;
                    if (STATS) q += r0[0] * r0[0] + r0[1] * r0[1] + r0[2] * r0[2] + r0[3] * r0[3] + r1[0] * r1[0] + r1[1] * r1[1] + r1[2] * r1[2] + r1[3] * r1[3];
                }
                if (STATS) { q += __shfl_xor(q, 16); q += __shfl_xor(q, 32); if (fq == 0) atomicAdd(ss + row, q); }
            }
        }
    }
};
struct EpiResFinal {
    static constexpr int NST = 16;
    const float* base; bf16_t* out16;
    DI void operator()(AccRef acc, const Unit& u, int wr, int wc, int fr, int fq) const {
        const int row0 = u.pm * 256 + wr * 64 + fr, col0 = u.pn * 256 + wc * 32 + 8 * fq;
#pragma unroll
        for (int ai = 0; ai < 2; ++ai) {
            f32x4 bv[4][2][2];
#pragma unroll
            for (int m = 0; m < 4; ++m)
#pragma unroll
                for (int bj = 0; bj < 2; ++bj) {
                    const size_t o = (size_t)(row0 + ai * 128 + m * 16) * DM + col0 + bj * 128;
                    bv[m][bj][0] = *(const f32x4*)(base + o); bv[m][bj][1] = *(const f32x4*)(base + o + 4);
                }
#pragma unroll
            for (int m = 0; m < 4; ++m)
#pragma unroll
                for (int bj = 0; bj < 2; ++bj) {
                    const size_t o = (size_t)(row0 + ai * 128 + m * 16) * DM + col0 + bj * 128;
                    const f32x4 r0 = bv[m][bj][0] + 0.5f * acc[ai][bj][m][0], r1 = bv[m][bj][1] + 0.5f * acc[ai][bj][m][1];
                    u32x4 w; w.x = pk_bf16(r0[0], r0[1]); w.y = pk_bf16(r0[2], r0[3]); w.z = pk_bf16(r1[0], r1[1]); w.w = pk_bf16(r1[2], r1[3]);
                    *(u32x4*)(out16 + o) = w;
                }
        }
    }
};
struct EpiQK {
    bf16_t* qkoA; bf16_t* qkoB; const float* cosT; const float* sinT; const float* ss;
    DI void operator()(AccRef acc, const Unit& u, int wr, int wc, int fr, int fq) const {
        const int X = u.pn >> 2, h = u.pn & 3, isk = wc >> 1, i0 = (wc & 1) * 32 + 8 * fq;
        bf16_t* dst = (X ? qkoB : qkoA) + h * 256 + isk * 128 + i0;
        const float qs0 = isk ? 1.0f : 0.08838834764831845f;
        const int row0 = u.pm * 256 + wr * 64 + fr;
        const RowScales rsc = load_rowscales(ss, row0);
#pragma unroll
        for (int ai = 0; ai < 2; ++ai) {
            f32x4 cs[4][2], sn[4][2];
            if (X == 0) {
#pragma unroll
                for (int m = 0; m < 4; ++m) {
                    const int pos = (row0 + ai * 128 + m * 16) & (SEQ - 1);
                    cs[m][0] = *(const f32x4*)(cosT + pos * 64 + i0); cs[m][1] = *(const f32x4*)(cosT + pos * 64 + i0 + 4);
                    sn[m][0] = *(const f32x4*)(sinT + pos * 64 + i0); sn[m][1] = *(const f32x4*)(sinT + pos * 64 + i0 + 4);
                }
            } else {
#pragma unroll
                for (int m = 0; m < 4; ++m) { cs[m][0] = cs[m][1] = (f32x4){1.f, 1.f, 1.f, 1.f}; sn[m][0] = sn[m][1] = (f32x4){0.f, 0.f, 0.f, 0.f}; }
            }
#pragma unroll
            for (int m = 0; m < 4; ++m) {
                const int row = row0 + ai * 128 + m * 16;
                const float qs = qs0 * rsc.r[ai][m];
                const f32x4 x1 = acc[ai][0][m][0], x2 = acc[ai][1][m][0], y1 = acc[ai][0][m][1], y2 = acc[ai][1][m][1];
                const f32x4 a1 = (x1 * cs[m][0] - x2 * sn[m][0]) * qs, a2 = (x2 * cs[m][0] + x1 * sn[m][0]) * qs;
                const f32x4 b1 = (y1 * cs[m][1] - y2 * sn[m][1]) * qs, b2 = (y2 * cs[m][1] + y1 * sn[m][1]) * qs;
                u32x4 w1, w2;
                w1.x = pk_bf16(a1[0], a1[1]); w1.y = pk_bf16(a1[2], a1[3]); w1.z = pk_bf16(b1[0], b1[1]); w1.w = pk_bf16(b1[2], b1[3]);
                w2.x = pk_bf16(a2[0], a2[1]); w2.y = pk_bf16(a2[2], a2[3]); w2.z = pk_bf16(b2[0], b2[1]); w2.w = pk_bf16(b2[2], b2[3]);
                *(u32x4*)(dst + (size_t)row * 1024) = w1;
                *(u32x4*)(dst + (size_t)row * 1024 + 64) = w2;
            }
        }
    }
};
struct EpiVT {
    bf16_t* vtA; bf16_t* vtB; const float* ss;
    DI void operator()(AccRef acc, const Unit& u, int wr, int wc, int fr, int fq) const {
        f32x4 ts[2][2];
#pragma unroll
        for (int bj = 0; bj < 2; ++bj) { const int tok = u.pn * 256 + bj * 128 + wc * 32 + 8 * fq; ts[bj][0] = *(const f32x4*)(ss + tok); ts[bj][1] = *(const f32x4*)(ss + tok + 4); }
#pragma unroll
        for (int bj = 0; bj < 2; ++bj)
#pragma unroll
            for (int n = 0; n < 2; ++n)
#pragma unroll
                for (int e = 0; e < 4; ++e) ts[bj][n][e] = rsqrtf(ts[bj][n][e] * (1.0f / 1024.0f) + 1e-6f);
#pragma unroll
        for (int ai = 0; ai < 2; ++ai)
#pragma unroll
            for (int m = 0; m < 4; ++m) {
                const int R = u.pm * 256 + ai * 128 + wr * 64 + m * 16 + fr, X = R >> 10, hv = R & 1023;
#pragma unroll
                for (int bj = 0; bj < 2; ++bj) {
                    const int tok = u.pn * 256 + bj * 128 + wc * 32 + 8 * fq, b = tok >> 13, s = tok & (SEQ - 1);
                    bf16_t* dst = (X ? vtB : vtA) + ((size_t)(((b * 4 + (hv >> 8)) * 128 + (s >> 6)) * 256 + (hv & 255))) * 64 + (s & 63);
                    const f32x4 v0 = acc[ai][bj][m][0] * ts[bj][0], v1 = acc[ai][bj][m][1] * ts[bj][1];
                    u32x4 w; w.x = pk_bf16(v0[0], v0[1]); w.y = pk_bf16(v0[2], v0[3]); w.z = pk_bf16(v1[0], v1[1]); w.w = pk_bf16(v1[2], v1[3]);
                    *(u32x4*)dst = w;
                }
            }
    }
};
struct EpiRGate {
    bf16_t* oA; bf16_t* oB; const float* ss;
    DI void operator()(AccRef acc, const Unit& u, int wr, int wc, int fr, int fq) const {
        const int row0 = u.pm * 256 + wr * 64 + fr;
        bf16_t* O = (u.pn < 4 ? oA : oB) + (u.pn & 3) * 256 + wc * 32 + 8 * fq;
        const RowScales rsc = load_rowscales(ss, row0);
#pragma unroll
        for (int ai = 0; ai < 2; ++ai) {
            u32x4 ov[4][2];
#pragma unroll
            for (int m = 0; m < 4; ++m)
#pragma unroll
                for (int bj = 0; bj < 2; ++bj) ov[m][bj] = *(const u32x4*)(O + (size_t)(row0 + ai * 128 + m * 16) * 1024 + bj * 128);
#pragma unroll
            for (int m = 0; m < 4; ++m)
#pragma unroll
                for (int bj = 0; bj < 2; ++bj) {
                    bf16_t* p = O + (size_t)(row0 + ai * 128 + m * 16) * 1024 + bj * 128;
                    const float rs = rsc.r[ai][m];
                    const u32x4 o = ov[m][bj]; const f32x4 r0 = acc[ai][bj][m][0] * rs, r1 = acc[ai][bj][m][1] * rs;
                    u32x4 w;
                    w.x = pk_bf16(fast_silu(r0[0]) * bf_lo(o.x), fast_silu(r0[1]) * bf_hi(o.x)); w.y = pk_bf16(fast_silu(r0[2]) * bf_lo(o.y), fast_silu(r0[3]) * bf_hi(o.y));
                    w.z = pk_bf16(fast_silu(r1[0]) * bf_lo(o.z), fast_silu(r1[1]) * bf_hi(o.z)); w.w = pk_bf16(fast_silu(r1[2]) * bf_lo(o.w), fast_silu(r1[3]) * bf_hi(o.w));
                    *(u32x4*)p = w;
                }
        }
    }
};
struct EpiGates {
    bf16_t* gab; const float* ss;
    DI void operator()(AccRef acc, const Unit& u, int wr, int wc, int fr, int fq) const {
        const int row0 = u.pm * 256 + wr * 64 + fr;
        bf16_t* Gp = gab + (size_t)(u.pm * 8 + u.pn) * 65536 + (wr * 64 + fr) * 256 + wc * 32 + 8 * fq;
        const RowScales rsc = load_rowscales(ss, row0);
#pragma unroll
        for (int ai = 0; ai < 2; ++ai)
#pragma unroll
            for (int m = 0; m < 4; ++m)
#pragma unroll
                for (int bj = 0; bj < 2; ++bj) {
                    const float rs = rsc.r[ai][m];
                    const f32x4 r0 = acc[ai][bj][m][0] * rs, r1 = acc[ai][bj][m][1] * rs;
                    u32x4 w;
                    w.x = pk_bf16(fast_sigmoid(r0[0]), fast_sigmoid(r0[1])); w.y = pk_bf16(fast_sigmoid(r0[2]), fast_sigmoid(r0[3]));
                    w.z = pk_bf16(fast_sigmoid(r1[0]), fast_sigmoid(r1[1])); w.w = pk_bf16(fast_sigmoid(r1[2]), fast_sigmoid(r1[3]));
                    *(u32x4*)(Gp + (ai * 128 + m * 16) * 256 + bj * 128) = w;
                }
    }
};
template <int SECOND> struct EpiMerge {
    const bf16_t* gab; bf16_t* mrg;
    DI void operator()(AccRef acc, const Unit& u, int wr, int wc, int fr, int fq) const {
        const int row0 = u.pm * 256 + wr * 64 + fr, col0 = u.pn * 256 + wc * 32 + 8 * fq;
#pragma unroll
        for (int ai = 0; ai < 2; ++ai)
#pragma unroll
            for (int mh = 0; mh < 2; ++mh) {
                u32x4 gv[2][2], mv[2][2];
#pragma unroll
                for (int mm = 0; mm < 2; ++mm)
#pragma unroll
                    for (int bj = 0; bj < 2; ++bj) {
                        const size_t row = (size_t)(row0 + ai * 128 + (mh * 2 + mm) * 16); const int col = col0 + bj * 128;
                        gv[mm][bj] = *(const u32x4*)(gab + (size_t)(u.pm * 8 + SECOND * 4 + u.pn) * 65536 + (wr * 64 + fr + ai * 128 + (mh * 2 + mm) * 16) * 256 + wc * 32 + 8 * fq + bj * 128);
                        if (SECOND) mv[mm][bj] = *(const u32x4*)(mrg + row * 1024 + col);
                    }
#pragma unroll
                for (int mm = 0; mm < 2; ++mm)
#pragma unroll
                    for (int bj = 0; bj < 2; ++bj) {
                        const int m = mh * 2 + mm;
                        const size_t row = (size_t)(row0 + ai * 128 + m * 16); const int col = col0 + bj * 128;
                        const u32x4 gt = gv[mm][bj];
                        const f32x4 r0 = acc[ai][bj][m][0], r1 = acc[ai][bj][m][1];
                        float v[8] = {bf_lo(gt.x) * r0[0], bf_hi(gt.x) * r0[1], bf_lo(gt.y) * r0[2], bf_hi(gt.y) * r0[3], bf_lo(gt.z) * r1[0], bf_hi(gt.z) * r1[1], bf_lo(gt.w) * r1[2], bf_hi(gt.w) * r1[3]};
                        if (SECOND) { const u32x4 o = mv[mm][bj]; v[0] += bf_lo(o.x); v[1] += bf_hi(o.x); v[2] += bf_lo(o.y); v[3] += bf_hi(o.y); v[4] += bf_lo(o.z); v[5] += bf_hi(o.z); v[6] += bf_lo(o.w); v[7] += bf_hi(o.w); }
                        u32x4 w; w.x = pk_bf16(v[0], v[1]); w.y = pk_bf16(v[2], v[3]); w.z = pk_bf16(v[4], v[5]); w.w = pk_bf16(v[6], v[7]);
                        *(u32x4*)(mrg + row * 1024 + col) = w;
                    }
            }
    }
};

template <class Epi> DI void run_gemm(LAS unsigned char* lds, const bf16_t* A, const bf16_t* Bt, int M, int N, int K, const Epi E) {
    pg8::Gemm g; g.A = A; g.Bt = Bt; g.M = M; g.N = N; g.K = K;
    pg8::StaticOrder S; S.init(M, N, (int)gridDim.x, (int)blockIdx.x);
    pg8::gemm_phase<Epi>(lds, g, S, E);
}

template <class Epi0, class Epi1> DI void run_gemm_dual(LAS unsigned char* lds, const bf16_t* A0, const bf16_t* Bt0, const bf16_t* A1, const bf16_t* Bt1, int M, int N, int K, const Epi0 E0, const Epi1 E1) {
    pg8::Gemm g0; g0.A = A0; g0.Bt = Bt0; g0.M = M; g0.N = N; g0.K = K;
    pg8::Gemm g1 = g0; g1.A = A1; g1.Bt = Bt1;
    pg8::StaticOrder S; S.init(M, N, (int)gridDim.x, (int)blockIdx.x);
    pg8::gemm_phase_dual<Epi0, Epi1>(lds, g0, g1, S, S, E0, E1);
}
template <class Epi0, class Epi1> DI void run_gemm_dual2(LAS unsigned char* lds, const bf16_t* A0, const bf16_t* Bt0, int M0, int N0, const bf16_t* A1, const bf16_t* Bt1, int M1, int N1, int K, const Epi0 E0, const Epi1 E1) {
    pg8::Gemm g0; g0.A = A0; g0.Bt = Bt0; g0.M = M0; g0.N = N0; g0.K = K;
    pg8::Gemm g1; g1.A = A1; g1.Bt = Bt1; g1.M = M1; g1.N = N1; g1.K = K;
    pg8::StaticOrder S0; S0.init(M0, N0, (int)gridDim.x, (int)blockIdx.x);
    pg8::StaticOrder S1; S1.init(M1, N1, (int)gridDim.x, (int)blockIdx.x);
    pg8::gemm_phase_dual<Epi0, Epi1>(lds, g0, g1, S0, S1, E0, E1);
}

DI void wprep_tile(LAS unsigned char* lds, const float* src, int col0, int ldw, int K, bf16_t* dst, int r0, int k0, const float* ksc) {
    const int t = opaque_tid(), c = t & 63, kk = t >> 6;
    float v[8];
#pragma unroll
    for (int i = 0; i < 8; ++i) v[i] = src[(size_t)(k0 + kk * 8 + i) * ldw + col0 + c];
    if (ksc) {
#pragma unroll
        for (int i = 0; i < 8; ++i) v[i] *= ksc[k0 + kk * 8 + i];
    }
    u32x4 w; w.x = pk_bf16(v[0], v[1]); w.y = pk_bf16(v[2], v[3]); w.z = pk_bf16(v[4], v[5]); w.w = pk_bf16(v[6], v[7]);
    *(LAS u32x4*)(lds + c * 144 + kk * 16) = w;
    __syncthreads();
    const int row = t >> 3, seg = t & 7;
    const u32x4 o = *(const LAS u32x4*)(lds + row * 144 + seg * 16);
    *(u32x4*)(dst + (size_t)(r0 + row) * K + k0 + seg * 8) = o;
    __syncthreads();
}
DI void wprep_tile4(LAS unsigned char* lds, const float* src, int col0, int ldw, int K, bf16_t* dst, int r0, int k0, const float* ksc) {
    const int t = opaque_tid(), c = t & 63, kk = t >> 6;
    float v[4][8];
#pragma unroll
    for (int q = 0; q < 4; ++q)
#pragma unroll
        for (int i = 0; i < 8; ++i) v[q][i] = src[(size_t)(k0 + q * 64 + kk * 8 + i) * ldw + col0 + c];
    if (ksc) {
#pragma unroll
        for (int q = 0; q < 4; ++q)
#pragma unroll
            for (int i = 0; i < 8; ++i) v[q][i] *= ksc[k0 + q * 64 + kk * 8 + i];
    }
#pragma unroll
    for (int q = 0; q < 4; ++q) {
        u32x4 w; w.x = pk_bf16(v[q][0], v[q][1]); w.y = pk_bf16(v[q][2], v[q][3]); w.z = pk_bf16(v[q][4], v[q][5]); w.w = pk_bf16(v[q][6], v[q][7]);
        *(LAS u32x4*)(lds + q * 9216 + c * 144 + kk * 16) = w;
    }
    __syncthreads();
    const int row = t >> 3, seg = t & 7;
#pragma unroll
    for (int q = 0; q < 4; ++q) {
        const u32x4 o = *(const LAS u32x4*)(lds + q * 9216 + row * 144 + seg * 16);
        *(u32x4*)(dst + (size_t)(r0 + row) * K + k0 + q * 64 + seg * 8) = o;
    }
    __syncthreads();
}
template <class F> DI void wjob(LAS unsigned char* lds, int& off, const int G, const int c, int nrb, int nkb, int K, int ldw, bf16_t* dst, const float* src, const float* ksc, F&& mapf) {
    const int nkb4 = nkb >> 2, ntl = nrb * nkb4;
    const int start = ((c - off) % G + G) % G;
    for (int t = start; t < ntl; t += G) { const int rb = t / nkb4, kb = t % nkb4; int col0, drow; mapf(rb, col0, drow); wprep_tile4(lds, src, col0, ldw, K, dst, drow, kb * 256, ksc); }
    off += ntl;
}
template <int PART> DI void wprep_jobs(const Args& a, LAS unsigned char* lds, const int G, const int c) {
    unsigned char* ws = a.ws;
    const float* win = a.in[6];
    int off = 0;
    auto mapW1 = [](int rb, int& col0, int& drow) { col0 = rb * 64; drow = (rb >> 1) * 256 + (rb & 1) * 64; };
    auto mapW3 = [](int rb, int& col0, int& drow) { col0 = rb * 64; drow = (rb >> 1) * 256 + 128 + (rb & 1) * 64; };
    auto mapId = [](int rb, int& col0, int& drow) { col0 = rb * 64; drow = rb * 64; };
    if (PART == 0) {
        wjob(lds, off, G, c, 44, 16, 1024, DFF, (bf16_t*)(ws + WS_W13_1), a.in[2], nullptr, mapW1);
        wjob(lds, off, G, c, 44, 16, 1024, DFF, (bf16_t*)(ws + WS_W13_1), a.in[3], nullptr, mapW3);
        wjob(lds, off, G, c, 16, 44, DFF, 1024, (bf16_t*)(ws + WS_W2T_1), a.in[4], nullptr, mapId);
        wjob(lds, off, G, c, 32, 16, 1024, DIN, (bf16_t*)(ws + WS_WQK), win, a.in[5], [](int rb, int& col0, int& drow) { const int r0 = rb * 64, tile = r0 >> 8, X = tile >> 2, h = tile & 3, seg = (r0 & 255) >> 6;
            col0 = (X ? 3072 : 0) + ((seg & 1) ? 512 : 0) + h * 128 + (seg >> 1) * 64; drow = r0; });
        wjob(lds, off, G, c, 32, 16, 1024, DIN, (bf16_t*)(ws + WS_WV), win, a.in[5], [](int rb, int& col0, int& drow) { const int r0 = rb * 64; col0 = (r0 < 1024) ? 1024 + r0 : 4096 + (r0 - 1024); drow = r0; });
    } else {
        wjob(lds, off, G, c, 64, 16, 1024, DIN, (bf16_t*)(ws + WS_WRG), win, a.in[5], [](int rb, int& col0, int& drow) { const int r0 = rb * 64, q = r0 >> 10, r = r0 & 1023; col0 = (q == 0 ? 2048 : q == 1 ? 5120 : q == 2 ? 6160 : 7184) + r; drow = r0; });
        wjob(lds, off, G, c, 16, 16, 1024, 1024, (bf16_t*)(ws + WS_WBR), a.in[10], nullptr, mapId);
        wjob(lds, off, G, c, 16, 16, 1024, 1024, (bf16_t*)(ws + WS_WBG), a.in[11], nullptr, mapId);
        wjob(lds, off, G, c, 16, 16, 1024, 1024, (bf16_t*)(ws + WS_WOUT), a.in[12], nullptr, mapId);
        wjob(lds, off, G, c, 44, 16, 1024, DFF, (bf16_t*)(ws + WS_W13_2), a.in[14], a.in[13], mapW1);
        wjob(lds, off, G, c, 44, 16, 1024, DFF, (bf16_t*)(ws + WS_W13_2), a.in[15], a.in[13], mapW3);
        wjob(lds, off, G, c, 16, 44, DFF, 1024, (bf16_t*)(ws + WS_W2T_2), a.in[16], nullptr, mapId);
    }
}
DI void wprep_phase(const Args& a, LAS unsigned char* lds) {
    unsigned char* ws = a.ws;
    const float* win = a.in[6];
    wprep_jobs<0>(a, lds, (int)gridDim.x, (int)blockIdx.x);
    {
        bf16_t* wlr = (bf16_t*)(ws + WS_WLR);
        for (int i = blockIdx.x * 512 + threadIdx.x; i < 16 * 1024; i += gridDim.x * 512) { const int r = i >> 10, k = i & 1023; wlr[i] = (bf16_t)(pk_bf16(win[(size_t)k * DIN + 6144 + r] * a.in[5][k], 0.f) & 0xffffu); }
    }
    { float* z = (float*)(ws + WS_SS1); for (int i = blockIdx.x * 512 + threadIdx.x; i < 2 * NTOK; i += gridDim.x * 512) z[i] = 0.f; }
    {
        float* ct = (float*)(ws + WS_ROTC); float* st = (float*)(ws + WS_ROTS);
        for (int i = blockIdx.x * 512 + threadIdx.x; i < SEQ * 64; i += gridDim.x * 512) {
            const int pos = i >> 6, f = i & 63;
            double inv = 1.0, cb = 0.8659643233600653;
#pragma unroll
            for (int bit = 0; bit < 6; ++bit) { if ((f >> bit) & 1) inv *= cb; cb *= cb; }
            const double rev = (double)pos * inv * 0.15915494309189535;
            const float r = (float)(rev - rint(rev));
            ct[i] = __builtin_amdgcn_cosf(r); st[i] = __builtin_amdgcn_sinf(r);
        }
    }
}

template <bool OUT_BF16> DI void rmsnorm_phase(const float* src, const float* w, void* dstv) {
    const int tid_ = opaque_tid(), lane = tid_ & 63, wid = tid_ >> 6;
    f32x4 wv[4];
#pragma unroll
    for (int j = 0; j < 4; ++j) wv[j] = *(const f32x4*)(w + j * 256 + lane * 4);
    for (int row = (blockIdx.x * 8 + wid) * 2; row < NTOK; row += gridDim.x * 16) {
        f32x4 v[2][4]; float ss[2] = {0.f, 0.f};
#pragma unroll
        for (int r = 0; r < 2; ++r)
#pragma unroll
            for (int j = 0; j < 4; ++j) v[r][j] = *(const f32x4*)(src + (size_t)(row + r) * DM + j * 256 + lane * 4);
#pragma unroll
        for (int r = 0; r < 2; ++r)
#pragma unroll
            for (int j = 0; j < 4; ++j) ss[r] += v[r][j][0] * v[r][j][0] + v[r][j][1] * v[r][j][1] + v[r][j][2] * v[r][j][2] + v[r][j][3] * v[r][j][3];
#pragma unroll
        for (int o = 32; o >= 1; o >>= 1) { ss[0] += __shfl_xor(ss[0], o); ss[1] += __shfl_xor(ss[1], o); }
#pragma unroll
        for (int r = 0; r < 2; ++r) {
            const float rs = rsqrtf(ss[r] * (1.0f / 1024.0f) + 1e-6f);
#pragma unroll
            for (int j = 0; j < 4; ++j) {
                const f32x4 y = v[r][j] * rs * wv[j];
                if (OUT_BF16) { u32x2 o; o.x = pk_bf16(y[0], y[1]); o.y = pk_bf16(y[2], y[3]); *(u32x2*)((bf16_t*)dstv + (size_t)(row + r) * DM + j * 256 + lane * 4) = o; }
                else *(f32x4*)((float*)dstv + (size_t)(row + r) * DM + j * 256 + lane * 4) = y;
            }
        }
    }
}

DI void final_norm_phase(const bf16_t* src, const float* w, float* dst) {
    const int tid_ = opaque_tid(), lane = tid_ & 63, wid = tid_ >> 6;
    f32x4 wv[2][2];
#pragma unroll
    for (int j = 0; j < 2; ++j) { wv[j][0] = *(const f32x4*)(w + j * 512 + lane * 8); wv[j][1] = *(const f32x4*)(w + j * 512 + lane * 8 + 4); }
    for (int row = (blockIdx.x * 8 + wid) * 2; row < NTOK; row += gridDim.x * 16) {
        u32x4 hv[2][2];
#pragma unroll
        for (int r = 0; r < 2; ++r)
#pragma unroll
            for (int j = 0; j < 2; ++j) hv[r][j] = *(const u32x4*)(src + (size_t)(row + r) * DM + j * 512 + lane * 8);
        float ss[2] = {0.f, 0.f};
        f32x4 v[2][2][2];
#pragma unroll
        for (int r = 0; r < 2; ++r)
#pragma unroll
            for (int j = 0; j < 2; ++j) {
                v[r][j][0] = bf_lo4(hv[r][j]); v[r][j][1] = bf_hi4(hv[r][j]);
#pragma unroll
                for (int e = 0; e < 4; ++e) ss[r] += v[r][j][0][e] * v[r][j][0][e] + v[r][j][1][e] * v[r][j][1][e];
            }
#pragma unroll
        for (int o = 32; o >= 1; o >>= 1) { ss[0] += __shfl_xor(ss[0], o); ss[1] += __shfl_xor(ss[1], o); }
#pragma unroll
        for (int r = 0; r < 2; ++r) {
            const float rs = rsqrtf(ss[r] * (1.0f / 1024.0f) + 1e-6f);
#pragma unroll
            for (int j = 0; j < 2; ++j) {
                *(f32x4*)(dst + (size_t)(row + r) * DM + j * 512 + lane * 8) = v[r][j][0] * rs * wv[j][0];
                *(f32x4*)(dst + (size_t)(row + r) * DM + j * 512 + lane * 8 + 4) = v[r][j][1] * rs * wv[j][1];
            }
        }
    }
}

DI void cum_phase(const Args& a, LAS unsigned char* lds) {
    const bf16_t* xn = (const bf16_t*)(a.ws + WS_XN); const bf16_t* wlr = (const bf16_t*)(a.ws + WS_WLR); _Float16* cumo = (_Float16*)(a.ws + WS_CUM);
    const int tid = opaque_tid(), lane = tid & 63, wid = tid >> 6, fr = lane & 15, g = lane >> 4;
    LAS float* lrp = (LAS float*)lds;
    const float* ss1 = (const float*)(a.ws + WS_SS1);
    float w2c[16];
#pragma unroll
    for (int r = 0; r < 16; ++r) w2c[r] = a.in[7][r * 512 + tid];
    const float bias = a.in[8][tid];
    for (int chunk = blockIdx.x; chunk < NTOK / 64; chunk += gridDim.x) {
        const int tok0 = chunk * 64, tt = wid & 3, kh = wid >> 2;
        f32x4 acc = {0.f, 0.f, 0.f, 0.f};
        const bf16_t* ap = xn + (size_t)(tok0 + tt * 16 + fr) * 1024 + kh * 512 + 8 * g;
        const bf16_t* bp = wlr + fr * 1024 + kh * 512 + 8 * g;
#pragma unroll
        for (int s = 0; s < 16; ++s) {
            const bf16x8 av = *(const bf16x8*)(ap + s * 32), bv = *(const bf16x8*)(bp + s * 32);
            acc = __builtin_amdgcn_mfma_f32_16x16x32_bf16(av, bv, acc, 0, 0, 0);
        }
#pragma unroll
        for (int i = 0; i < 4; ++i) lrp[(kh * 64 + tt * 16 + 4 * g + i) * 16 + fr] = acc[i] * rowscale(ss1, tok0 + tt * 16 + 4 * g + i);
        __syncthreads();
        { const float s0 = lrp[tid] + lrp[1024 + tid], s1 = lrp[512 + tid] + lrp[1536 + tid]; __syncthreads(); lrp[tid] = s0; lrp[512 + tid] = s1; }
        __syncthreads();
        float cum = 0.f;
        for (int t0 = 0; t0 < 64; t0 += 8) {
            float ls[8];
#pragma unroll
            for (int uu = 0; uu < 8; ++uu) {
                float z = bias;
#pragma unroll
                for (int q = 0; q < 4; ++q) {
                    const f32x4 l0 = *(const LAS f32x4*)(lrp + (t0 + uu) * 16 + q * 4);
#pragma unroll
                    for (int e = 0; e < 4; ++e) z += l0[e] * w2c[q * 4 + e];
                }
                ls[uu] = (fminf(z, 0.f) - __logf(1.0f + __expf(-fabsf(z)))) * (1.0f / 16.0f);
            }
#pragma unroll
            for (int uu = 0; uu < 8; ++uu) {
                cum += ls[uu];
                cumo[(size_t)(tok0 + t0 + uu) * 512 + tid] = (_Float16)(cum * 1.4426950408889634f);
            }
        }
        __syncthreads();
    }
}

constexpr int SC_QP = 0, SC_QM = 17408, SC_KP = 34816, SC_KM = 52224, SC_KT = 69632, SC_SC = 88064, SC_ST = 97280, SC_EL = 101376;
constexpr int SC_KT2 = 0, SC_EL2 = 36864;
constexpr int NSEG = 4, SEGC = 32;
DI float ret_logg(int h) { return (h == 0) ? -0.0317486983145803f : (h == 1) ? -0.015748356968139168f : (h == 2) ? -0.007843177461025893f : -0.003913899321136329f; }

DI void scan_pass1(const Args& a, LAS unsigned char* lds) {
    const int tid = opaque_tid(), lane = tid & 63, w = __builtin_amdgcn_readfirstlane(tid >> 6), fr = lane & 15, g = lane >> 4;
    const int mp = tid >> 4, dseg = tid & 15, m0 = 2 * mp, d0 = 8 * dseg;
    for (int item = blockIdx.x; item < 64 * (NSEG - 1); item += gridDim.x) {
        const int chain = item & 63, seg = item >> 6, X = chain >> 5, b = (chain >> 2) & 7, h = chain & 3;
        const bf16_t* qko = (const bf16_t*)(a.ws + (X ? WS_QKOB : WS_QKOA)) + (size_t)b * SEQ * 1024 + h * 256;
        const bf16_t* vt = (const bf16_t*)(a.ws + (X ? WS_VTB : WS_VTA)) + (size_t)((b * 4 + h) * 256) * SEQ;
        const _Float16* cumg = (const _Float16*)(a.ws + WS_CUM) + (size_t)b * SEQ * 512 + h * 128;
        const float logg = ret_logg(h);
        f32x4 S[8][2];
#pragma unroll
        for (int i = 0; i < 8; ++i) { S[i][0] = (f32x4){0.f, 0.f, 0.f, 0.f}; S[i][1] = (f32x4){0.f, 0.f, 0.f, 0.f}; }
        float dsum[8];
#pragma unroll
        for (int j = 0; j < 8; ++j) dsum[j] = 0.f;
        u32x4 pk0, pk1; u32x4 pc[2], pl; bf16x8 vf[2][2];
        auto load_chunk = [&](int ch) {
            const bf16_t* r0 = qko + (size_t)(ch * 64 + m0) * 1024 + d0 + 128;
            pk0 = *(const u32x4*)r0; pk1 = *(const u32x4*)(r0 + 1024);
            if (X) {
                const _Float16* c0 = cumg + (size_t)(ch * 64 + m0) * 512 + d0;
                pc[0] = *(const u32x4*)c0; pc[1] = *(const u32x4*)(c0 + 512);
                pl = *(const u32x4*)(cumg + (size_t)(ch * 64 + 63) * 512 + d0);
            }
        };
        auto load_vt = [&](int ch) {
#pragma unroll
            for (int vtile = 0; vtile < 2; ++vtile)
#pragma unroll
                for (int ks = 0; ks < 2; ++ks) vf[vtile][ks] = *(const bf16x8*)(vt + ((size_t)ch * 256 + 32 * w + 8 * (fr >> 2) + 4 * vtile + (fr & 3)) * 64 + 32 * ks + 8 * g);
        };
        const int c0 = seg * SEGC;
        load_chunk(c0); load_vt(c0);
        for (int ci = 0; ci < SEGC; ++ci) {
            const int ch = c0 + ci, kto = SC_KT2 + (ci & 1) * 18432, elo = SC_EL2 + (ci & 1) * 512;
            {
                float kt[2][8];
#pragma unroll
                for (int r = 0; r < 2; ++r) {
                    const u32x4 kw = r ? pk1 : pk0;
                    const float kv[8] = {bf_lo(kw.x), bf_hi(kw.x), bf_lo(kw.y), bf_hi(kw.y), bf_lo(kw.z), bf_hi(kw.z), bf_lo(kw.w), bf_hi(kw.w)};
                    if (X) {
#pragma unroll
                        for (int j = 0; j < 8; ++j) kt[r][j] = kv[j] * __builtin_amdgcn_exp2f(h_get(pl, j) - h_get(pc[r], j));
                    } else {
                        const float el = __expf((float)(63 - m0 - r) * logg);
#pragma unroll
                        for (int j = 0; j < 8; ++j) kt[r][j] = kv[j] * el;
                    }
                }
#pragma unroll
                for (int j = 0; j < 8; ++j) {
                    const int d = d0 + j;
                    *(LAS unsigned*)(lds + kto + d * 144 + (((m0 >> 3) ^ ((d >> 4) & 7)) * 16) + (m0 & 7) * 2) = pk_bf16(kt[0][j], kt[1][j]);
                }
                if (X) {
#pragma unroll
                    for (int j = 0; j < 8; ++j) dsum[j] += h_get(pl, j);
                }
                if (mp == 31) {
#pragma unroll
                    for (int j = 0; j < 8; ++j) { *(LAS float*)(lds + elo + (d0 + j) * 4) = X ? __builtin_amdgcn_exp2f(h_get(pl, j)) : __expf(64.0f * logg); }
                }
            }
            __syncthreads();
            load_chunk(ci + 1 < SEGC ? ch + 1 : ch);
#pragma unroll
            for (int dt = 0; dt < 8; ++dt) {
                const f32x4 el = *(const LAS f32x4*)(lds + elo + (16 * dt + 4 * g) * 4);
                S[dt][0] *= el; S[dt][1] *= el;
#pragma unroll
                for (int ks = 0; ks < 2; ++ks) {
                    const bf16x8 ak = *(const LAS bf16x8*)(lds + kto + (16 * dt + fr) * 144 + (((4 * ks + g) ^ (dt & 7)) * 16));
#pragma unroll
                    for (int vtile = 0; vtile < 2; ++vtile) S[dt][vtile] = __builtin_amdgcn_mfma_f32_16x16x32_bf16(ak, vf[vtile][ks], S[dt][vtile], 0, 0, 0);
                }
            }
            load_vt(ci + 1 < SEGC ? ch + 1 : ch);
        }
        float* st = (float*)(a.ws + WS_STATE) + (size_t)(chain * (NSEG - 1) + seg) * 32768;
#pragma unroll
        for (int dt = 0; dt < 8; ++dt)
#pragma unroll
            for (int vtile = 0; vtile < 2; ++vtile) *(f32x4*)(st + ((dt * 2 + vtile) * 512 + tid) * 4) = S[dt][vtile];
        if (mp == 0) {
            float* dg = (float*)(a.ws + WS_DSEG) + (chain * (NSEG - 1) + seg) * 128 + d0;
#pragma unroll
            for (int j = 0; j < 8; ++j) dg[j] = X ? __builtin_amdgcn_exp2f(dsum[j]) : __expf((float)(64 * SEGC) * logg);
        }
        __syncthreads();
    }
}

template <int X> DI void scan_item2(const Args& a, LAS unsigned char* lds, const int chain, const int seg) {
    const int tid = opaque_tid(), lane = tid & 63, w = __builtin_amdgcn_readfirstlane(tid >> 6), fr = lane & 15, g = lane >> 4;
    const int mp = tid >> 4, dseg = tid & 15, m0 = 2 * mp, d0 = 8 * dseg;
    {
        const int b = (chain >> 2) & 7, h = chain & 3;
        bf16_t* qko = (bf16_t*)(a.ws + (X ? WS_QKOB : WS_QKOA)) + (size_t)b * SEQ * 1024 + h * 256;
        const bf16_t* vt = (const bf16_t*)(a.ws + (X ? WS_VTB : WS_VTA)) + (size_t)((b * 4 + h) * 256) * SEQ;
        const _Float16* cumg = (const _Float16*)(a.ws + WS_CUM) + (size_t)b * SEQ * 512 + h * 128;
        const float logg = ret_logg(h);

        f32x4 S[8][2];
#pragma unroll
        for (int i = 0; i < 8; ++i) { S[i][0] = (f32x4){0.f, 0.f, 0.f, 0.f}; S[i][1] = (f32x4){0.f, 0.f, 0.f, 0.f}; }
        for (int j = 0; j < seg; ++j) {
            const float* st = (const float*)(a.ws + WS_STATE) + (size_t)(chain * (NSEG - 1) + j) * 32768;
            const float* dg = (const float*)(a.ws + WS_DSEG) + (chain * (NSEG - 1) + j) * 128;
#pragma unroll
            for (int dt = 0; dt < 8; ++dt) {
                const f32x4 dj = *(const f32x4*)(dg + 16 * dt + 4 * g);
#pragma unroll
                for (int vtile = 0; vtile < 2; ++vtile) S[dt][vtile] = S[dt][vtile] * dj + *(const f32x4*)(st + ((dt * 2 + vtile) * 512 + tid) * 4);
            }
        }

        u32x4 pq0, pq1, pk0, pk1; u32x4 pc[2], pl; bf16x8 vf[2][2];
        auto load_chunk = [&](int ch) {
            const bf16_t* r0 = qko + (size_t)(ch * 64 + m0) * 1024 + d0;
            pq0 = *(const u32x4*)r0; pk0 = *(const u32x4*)(r0 + 128); pq1 = *(const u32x4*)(r0 + 1024); pk1 = *(const u32x4*)(r0 + 1024 + 128);
            if (X) {
                const _Float16* c0 = cumg + (size_t)(ch * 64 + m0) * 512 + d0;
                pc[0] = *(const u32x4*)c0; pc[1] = *(const u32x4*)(c0 + 512);
                pl = *(const u32x4*)(cumg + (size_t)(ch * 64 + 63) * 512 + d0);
            }
        };
        auto load_vt = [&](int ch) {
#pragma unroll
            for (int vtile = 0; vtile < 2; ++vtile)
#pragma unroll
                for (int ks = 0; ks < 2; ++ks) vf[vtile][ks] = *(const bf16x8*)(vt + ((size_t)ch * 256 + 32 * w + 8 * (fr >> 2) + 4 * vtile + (fr & 3)) * 64 + 32 * ks + 8 * g);
        };
        const int cbeg = seg * SEGC, cend = cbeg + SEGC;
        load_chunk(cbeg); load_vt(cbeg);

        for (int ch = cbeg; ch < cend; ++ch) {
            {
                float kt[2][8];
                float elj[8];
                if (X) {
#pragma unroll
                    for (int j = 0; j < 8; ++j) elj[j] = __builtin_amdgcn_exp2f(h_get(pl, j));
                } else {
                    const float e = __expf(64.0f * logg);
#pragma unroll
                    for (int j = 0; j < 8; ++j) elj[j] = e;
                }
#pragma unroll
                for (int r = 0; r < 2; ++r) {
                    const u32x4 qw = r ? pq1 : pq0, kw = r ? pk1 : pk0;
                    const float qv[8] = {bf_lo(qw.x), bf_hi(qw.x), bf_lo(qw.y), bf_hi(qw.y), bf_lo(qw.z), bf_hi(qw.z), bf_lo(qw.w), bf_hi(qw.w)};
                    const float kv[8] = {bf_lo(kw.x), bf_hi(kw.x), bf_lo(kw.y), bf_hi(kw.y), bf_lo(kw.z), bf_hi(kw.z), bf_lo(kw.w), bf_hi(kw.w)};
                    float qp[8], qm[8], kp[8], km[8];
                    if (X) {
#pragma unroll
                        for (int j = 0; j < 8; ++j) {
                            const float ep = __builtin_amdgcn_exp2f(h_get(pc[r], j)), em = __builtin_amdgcn_rcpf(ep);
                            qp[j] = qv[j] * ep; qm[j] = qv[j] * em; kp[j] = kv[j] * ep; km[j] = kv[j] * em; kt[r][j] = km[j] * elj[j];
                        }
                    } else {
                        const float c = (float)(m0 + r + 1) * logg, ep = __expf(c), em = __expf(-c), el = __expf((float)(63 - m0 - r) * logg);
#pragma unroll
                        for (int j = 0; j < 8; ++j) { qp[j] = qv[j] * ep; qm[j] = qv[j] * em; kp[j] = kv[j] * ep; km[j] = kv[j] * em; kt[r][j] = kv[j] * el; }
                    }
                    const int off = (m0 + r) * 272 + dseg * 16;
                    u32x4 o;
                    o.x = pk_bf16(qp[0], qp[1]); o.y = pk_bf16(qp[2], qp[3]); o.z = pk_bf16(qp[4], qp[5]); o.w = pk_bf16(qp[6], qp[7]); *(LAS u32x4*)(lds + SC_QP + off) = o;
                    o.x = pk_bf16(qm[0], qm[1]); o.y = pk_bf16(qm[2], qm[3]); o.z = pk_bf16(qm[4], qm[5]); o.w = pk_bf16(qm[6], qm[7]); *(LAS u32x4*)(lds + SC_QM + off) = o;
                    o.x = pk_bf16(kp[0], kp[1]); o.y = pk_bf16(kp[2], kp[3]); o.z = pk_bf16(kp[4], kp[5]); o.w = pk_bf16(kp[6], kp[7]); *(LAS u32x4*)(lds + SC_KP + off) = o;
                    o.x = pk_bf16(km[0], km[1]); o.y = pk_bf16(km[2], km[3]); o.z = pk_bf16(km[4], km[5]); o.w = pk_bf16(km[6], km[7]); *(LAS u32x4*)(lds + SC_KM + off) = o;
                }
#pragma unroll
                for (int j = 0; j < 8; ++j) {
                    const int d = d0 + j;
                    *(LAS unsigned*)(lds + SC_KT + d * 144 + (((m0 >> 3) ^ ((d >> 4) & 7)) * 16) + (m0 & 7) * 2) = pk_bf16(kt[0][j], kt[1][j]);
                }
                if (mp == 31) {
#pragma unroll
                    for (int j = 0; j < 8; ++j) *(LAS float*)(lds + SC_EL + (d0 + j) * 4) = elj[j];
                }
            }
            __syncthreads();
            load_chunk(ch + 1 < cend ? ch + 1 : ch);
#pragma unroll
            for (int tt = 0; tt < 2; ++tt) {
                const int t = 2 * w + tt, mt = t >> 2, nt = t & 3;
                f32x4 t1 = {0.f, 0.f, 0.f, 0.f}, t2 = {0.f, 0.f, 0.f, 0.f};
                if (nt >= mt) {
#pragma unroll
                    for (int kk = 0; kk < 4; ++kk) {
                        const int ao = (16 * mt + fr) * 272 + (32 * kk + 8 * g) * 2, bo = (16 * nt + fr) * 272 + (32 * kk + 8 * g) * 2;
                        const bf16x8 akm = *(const LAS bf16x8*)(lds + SC_KM + ao), bqp = *(const LAS bf16x8*)(lds + SC_QP + bo);
                        t1 = __builtin_amdgcn_mfma_f32_16x16x32_bf16(akm, bqp, t1, 0, 0, 0);
                    }
                }
                if (nt <= mt) {
#pragma unroll
                    for (int kk = 0; kk < 4; ++kk) {
                        const int ao = (16 * mt + fr) * 272 + (32 * kk + 8 * g) * 2, bo = (16 * nt + fr) * 272 + (32 * kk + 8 * g) * 2;
                        const bf16x8 akp = *(const LAS bf16x8*)(lds + SC_KP + ao), bqm = *(const LAS bf16x8*)(lds + SC_QM + bo);
                        t2 = __builtin_amdgcn_mfma_f32_16x16x32_bf16(akp, bqm, t2, 0, 0, 0);
                    }
                }
                const int n = 16 * nt + fr, mb = 16 * mt + 4 * g;
                float sv[4];
#pragma unroll
                for (int i = 0; i < 4; ++i) sv[i] = (n >= mb + i) ? t1[i] : t2[i];
                u32x2 o; o.x = pk_bf16(sv[0], sv[1]); o.y = pk_bf16(sv[2], sv[3]);
                *(LAS u32x2*)(lds + SC_SC + n * 144 + mb * 2) = o;
            }
            __syncthreads();
            f32x4 oacc[2][4];
#pragma unroll
            for (int vtile = 0; vtile < 2; ++vtile)
#pragma unroll
                for (int nt = 0; nt < 4; ++nt) oacc[vtile][nt] = (f32x4){0.f, 0.f, 0.f, 0.f};
#pragma unroll
            for (int ks = 0; ks < 2; ++ks)
#pragma unroll
                for (int nt = 0; nt < 4; ++nt) {
                    const bf16x8 bs = *(const LAS bf16x8*)(lds + SC_SC + (16 * nt + fr) * 144 + ks * 64 + g * 16);
#pragma unroll
                    for (int vtile = 0; vtile < 2; ++vtile) oacc[vtile][nt] = __builtin_amdgcn_mfma_f32_16x16x32_bf16(vf[vtile][ks], bs, oacc[vtile][nt], 0, 0, 0);
                }
#pragma unroll
            for (int kk = 0; kk < 4; ++kk) {
                bf16x8 sa[2];
#pragma unroll
                for (int vtile = 0; vtile < 2; ++vtile) {
                    const f32x4 s0 = S[2 * kk][vtile], s1 = S[2 * kk + 1][vtile];
                    u32x4 p; p.x = pk_bf16(s0[0], s0[1]); p.y = pk_bf16(s0[2], s0[3]); p.z = pk_bf16(s1[0], s1[1]); p.w = pk_bf16(s1[2], s1[3]);
                    sa[vtile] = __builtin_bit_cast(bf16x8, p);
                }
#pragma unroll
                for (int nt = 0; nt < 4; ++nt) {
                    const int qo = SC_QP + (16 * nt + fr) * 272 + (32 * kk + 4 * g) * 2;
                    const u32x2 lo = *(const LAS u32x2*)(lds + qo), hi = *(const LAS u32x2*)(lds + qo + 32);
                    u32x4 p; p.x = lo.x; p.y = lo.y; p.z = hi.x; p.w = hi.y;
                    const bf16x8 bq = __builtin_bit_cast(bf16x8, p);
#pragma unroll
                    for (int vtile = 0; vtile < 2; ++vtile) oacc[vtile][nt] = __builtin_amdgcn_mfma_f32_16x16x32_bf16(sa[vtile], bq, oacc[vtile][nt], 0, 0, 0);
                }
            }
#pragma unroll
            for (int dt = 0; dt < 8; ++dt) {
                const f32x4 el = *(const LAS f32x4*)(lds + SC_EL + (16 * dt + 4 * g) * 4);
                S[dt][0] *= el; S[dt][1] *= el;
#pragma unroll
                for (int ks = 0; ks < 2; ++ks) {
                    const bf16x8 ak = *(const LAS bf16x8*)(lds + SC_KT + (16 * dt + fr) * 144 + (((4 * ks + g) ^ (dt & 7)) * 16));
#pragma unroll
                    for (int vtile = 0; vtile < 2; ++vtile) S[dt][vtile] = __builtin_amdgcn_mfma_f32_16x16x32_bf16(ak, vf[vtile][ks], S[dt][vtile], 0, 0, 0);
                }
            }
            load_vt(ch + 1 < cend ? ch + 1 : ch);
#pragma unroll
            for (int nt = 0; nt < 4; ++nt) {
                float s = 0.f, q = 0.f;
#pragma unroll
                for (int vtile = 0; vtile < 2; ++vtile)
#pragma unroll
                    for (int i = 0; i < 4; ++i) { const float x = oacc[vtile][nt][i]; s += x; q += x * x; }
                s += __shfl_xor(s, 16); q += __shfl_xor(q, 16); s += __shfl_xor(s, 32); q += __shfl_xor(q, 32);
                if (g == 0) { f32x2 sq = {s, q}; *(LAS f32x2*)(lds + SC_ST + ((16 * nt + fr) * 8 + w) * 8) = sq; }
            }
            __syncthreads();
            f32x4 nw[2];
#pragma unroll
            for (int vtile = 0; vtile < 2; ++vtile) nw[vtile] = X ? *(const f32x4*)(a.in[9] + 32 * w + 8 * g + 4 * vtile) : (f32x4){1.f, 1.f, 1.f, 1.f};
#pragma unroll
            for (int nt = 0; nt < 4; ++nt) {
                const int n = 16 * nt + fr;
                float s = 0.f, q = 0.f;
#pragma unroll
                for (int ww = 0; ww < 4; ++ww) { const f32x4 p = *(const LAS f32x4*)(lds + SC_ST + n * 64 + ww * 16); s += p[0] + p[2]; q += p[1] + p[3]; }
                float mu, rs;
                if (X) { mu = 0.f; rs = rsqrtf(q * (1.0f / 256.0f) + 1e-6f); }
                else { mu = s * (1.0f / 256.0f); const float var = fmaxf(q * (1.0f / 256.0f) - mu * mu, 0.f); rs = rsqrtf(var + 1e-6f); }
                const f32x4 y0 = (oacc[0][nt] - mu) * rs * nw[0], y1 = (oacc[1][nt] - mu) * rs * nw[1];
                u32x4 o; o.x = pk_bf16(y0[0], y0[1]); o.y = pk_bf16(y0[2], y0[3]); o.z = pk_bf16(y1[0], y1[1]); o.w = pk_bf16(y1[2], y1[3]);
                *(u32x4*)(qko + (size_t)(ch * 64 + n) * 1024 + 32 * w + 8 * g) = o;
            }
        }
        __syncthreads();
    }
}
DI void scan_pass2(const Args& a, LAS unsigned char* lds) {
    for (int item = blockIdx.x; item < 64 * NSEG; item += gridDim.x) {
        const int chain = item & 63, seg = item >> 6;
        if (chain >> 5) scan_item2<1>(a, lds, chain, seg); else scan_item2<0>(a, lds, chain, seg);
    }
}

#define XB_TMO      128
#define XB_XCNT(j)  (256  + 64 * (j))
#define XB_XSUB(j)  (1280 + 64 * (j))
#define XB_XGEN(j)  (2304 + 64 * (j))
#define XB_TOP      3328
#define XB_TOPGEN   3392
#define XCD_BAR_WORDS 3456
#define XB_SPIN_CAP (1u << 22)
DI unsigned xb_ld(unsigned* p)              { return __hip_atomic_load(p, __ATOMIC_RELAXED, __HIP_MEMORY_SCOPE_AGENT); }
DI unsigned xb_add(unsigned* p, unsigned v) { return __hip_atomic_fetch_add(p, v, __ATOMIC_RELAXED, __HIP_MEMORY_SCOPE_AGENT); }
DI unsigned xb_xcc_id() { return (unsigned)__builtin_amdgcn_s_getreg((3 << 11) | 20) & 0xFu; }
#define XB_SPIN(cond, bar) do { unsigned _sp = 0; while (cond) { __builtin_amdgcn_s_sleep(1); \
    if ((++_sp & 255u) == 0u) { if (xb_ld(&(bar)[XB_TMO])) break; if (_sp > XB_SPIN_CAP) { atomicAdd(&(bar)[XB_TMO], 1u); break; } } } } while (0)
struct XcdBarrier { unsigned* bar; unsigned x; volatile LAS unsigned* st; };
DI XcdBarrier xcd_barrier_post(unsigned* bar, volatile LAS unsigned* st) {
    XcdBarrier b; b.bar = bar; b.x = xb_xcc_id(); b.st = st;
    if (threadIdx.x == 0) (void)xb_add(&bar[XB_XCNT(b.x)], 1u);
    return b;
}
DI void xcd_barrier_complete(unsigned* bar, unsigned x, unsigned& nloc, unsigned& nx) {
    const unsigned G = gridDim.x * gridDim.y * gridDim.z;
    unsigned sum, cnt, mine, sp = 0u;
    for (;;) {
        sum = 0u; cnt = 0u; mine = 0u;
#pragma unroll
        for (unsigned j = 0; j < 16; ++j) { const unsigned c = xb_ld(&bar[XB_XCNT(j)]); sum += c; cnt += (c > 0u) ? 1u : 0u; mine = (j == x) ? c : mine; }
        if (sum == G) break;
        __builtin_amdgcn_s_sleep(1);
        if ((++sp & 255u) == 0u) { if (xb_ld(&bar[XB_TMO])) break; if (sp > XB_SPIN_CAP) { atomicAdd(&bar[XB_TMO], 1u); break; } }
    }
    nloc = mine > 0u ? mine : 1u; nx = cnt > 0u ? cnt : 1u;
}
DI void xcd_barrier(const XcdBarrier& b) {
    asm volatile("s_waitcnt vmcnt(0)" ::: "memory");
    __syncthreads();
    if (threadIdx.x == 0) {
        unsigned* bar = b.bar;
        __builtin_amdgcn_s_waitcnt(0);
        unsigned nloc = b.st[0], nx = b.st[1];
        if (nloc == 0u) { xcd_barrier_complete(bar, b.x, nloc, nx); b.st[0] = nloc; b.st[1] = nx; }
        const unsigned old = xb_add(&bar[XB_XSUB(b.x)], 1u);
        const unsigned gen = old / nloc;
        if (old + 1u == (gen + 1u) * nloc) {
            __builtin_amdgcn_fence(__ATOMIC_RELEASE, "agent");
            asm volatile("s_waitcnt vmcnt(0)" ::: "memory");
            const unsigned og = xb_add(&bar[XB_TOP], 1u);
            const unsigned tg = og / nx;
            if (og + 1u == (tg + 1u) * nx) xb_add(&bar[XB_TOPGEN], 1u);
            else XB_SPIN(xb_ld(&bar[XB_TOPGEN]) == tg, bar);
            __builtin_amdgcn_fence(__ATOMIC_ACQUIRE, "agent");
            xb_add(&bar[XB_XGEN(b.x)], 1u);
            asm volatile("s_waitcnt vmcnt(0)" ::: "memory");
        } else {
            XB_SPIN(xb_ld(&bar[XB_XGEN(b.x)]) == gen, bar);
            __builtin_amdgcn_fence(__ATOMIC_ACQUIRE, "agent");
            asm volatile("s_waitcnt vmcnt(0)" ::: "memory");
        }
    }
    __syncthreads();
}

__global__ void __launch_bounds__(512, 2) fwd_megakernel(Args a) {
    extern __shared__ __attribute__((aligned(16))) unsigned char shm[];
    LAS unsigned char* lds = (LAS unsigned char*)shm;
    cg::grid_group grid = cg::this_grid();
    unsigned char* ws = a.ws;
    bf16_t* XN = (bf16_t*)(ws + WS_XN);
    bf16_t* G = (bf16_t*)(ws + WS_G);
    bf16_t* QKOA = (bf16_t*)(ws + WS_QKOA); bf16_t* QKOB = (bf16_t*)(ws + WS_QKOB);
    bf16_t* GAB = (bf16_t*)(ws + WS_GAB); bf16_t* MRG = (bf16_t*)(ws + WS_MRG);
    float* SS1 = (float*)(ws + WS_SS1); float* SS2 = (float*)(ws + WS_SS2);

    if (threadIdx.x < 4) ((volatile LAS unsigned*)(lds + 131072))[threadIdx.x] = 0u;
    __syncthreads();
    const XcdBarrier xb = xcd_barrier_post((unsigned*)(ws + WS_BAR), (volatile LAS unsigned*)(lds + 131072));
    wprep_phase(a, lds);
    rmsnorm_phase<true>(a.in[0], a.in[1], XN);
    if (a.ws == nullptr) grid.sync();
    xcd_barrier(xb);
    { EpiSwiGLU<false> e; e.G = G; e.ss = nullptr; run_gemm(lds, XN, (const bf16_t*)(ws + WS_W13_1), NTOK, 5632, 1024, e); }
    xcd_barrier(xb);
    { EpiRes16<true, true, true> e; e.basef = a.in[0]; e.xnb = XN; e.ss = SS1; run_gemm(lds, G, (const bf16_t*)(ws + WS_W2T_1), NTOK, 1024, DFF, e); }
    xcd_barrier(xb);
    { EpiQK e0; e0.qkoA = QKOA; e0.qkoB = QKOB; e0.cosT = (const float*)(ws + WS_ROTC); e0.sinT = (const float*)(ws + WS_ROTS); e0.ss = SS1;
      EpiVT e1; e1.vtA = (bf16_t*)(ws + WS_VTA); e1.vtB = (bf16_t*)(ws + WS_VTB); e1.ss = SS1;
      run_gemm_dual2(lds, XN, (const bf16_t*)(ws + WS_WQK), NTOK, 2048, (const bf16_t*)(ws + WS_WV), XN, 2048, NTOK, 1024, e0, e1); }
    cum_phase(a, lds);
    xcd_barrier(xb);
    scan_pass1(a, lds);
    {
        const int nit = 64 * (NSEG - 1), G = (int)gridDim.x;
        if (G > nit) { if ((int)blockIdx.x >= nit) wprep_jobs<1>(a, lds, G - nit, (int)blockIdx.x - nit); }
        else wprep_jobs<1>(a, lds, G, (int)blockIdx.x);
    }
    xcd_barrier(xb);
    scan_pass2(a, lds);
    xcd_barrier(xb);
    { EpiRGate e0; e0.oA = QKOA; e0.oB = QKOB; e0.ss = SS1; EpiGates e1; e1.gab = GAB; e1.ss = SS1;
      run_gemm_dual(lds, XN, (const bf16_t*)(ws + WS_WRG), XN, (const bf16_t*)(ws + WS_WRG + 4 * SZ_1K / 2), NTOK, 2048, 1024, e0, e1); }
    xcd_barrier(xb);
    { EpiMerge<0> e0; e0.gab = GAB; e0.mrg = MRG; EpiMerge<1> e1; e1.gab = GAB; e1.mrg = MRG;
      run_gemm_dual(lds, QKOA, (const bf16_t*)(ws + WS_WBR), QKOB, (const bf16_t*)(ws + WS_WBG), NTOK, 1024, 1024, e0, e1); }
    xcd_barrier(xb);
    { EpiRes16<true, false, false> e; e.basef = nullptr; e.xnb = XN; e.ss = SS2; run_gemm(lds, MRG, (const bf16_t*)(ws + WS_WOUT), NTOK, 1024, 1024, e); }
    xcd_barrier(xb);
    { EpiSwiGLU<true> e; e.G = G; e.ss = SS2; run_gemm(lds, XN, (const bf16_t*)(ws + WS_W13_2), NTOK, 5632, 1024, e); }
    xcd_barrier(xb);
    { EpiRes16<false, true, false> e; e.basef = nullptr; e.xnb = XN; e.ss = nullptr; run_gemm(lds, G, (const bf16_t*)(ws + WS_W2T_2), NTOK, 1024, DFF, e); }
    xcd_barrier(xb);
    final_norm_phase(XN, a.in[17], a.out);
}

extern "C" void kernel_launch(void* const* d_in, const int* in_sizes, int n_in, void* d_out, int out_size, void* d_ws, size_t ws_size, hipStream_t stream) {
    static int grid_blocks = 0;
    if (grid_blocks == 0) {
        if (n_in != 18 || ws_size < WS_END) { fprintf(stderr, "kernel_launch: unexpected n_in %d / ws_size %zu (need %zu)\n", n_in, ws_size, (size_t)WS_END); grid_blocks = -1; return; }
        int dev = 0, cus = 0, per_cu = 0;
        hipGetDevice(&dev);
        hipDeviceGetAttribute(&cus, hipDeviceAttributeMultiprocessorCount, dev);
        if (hipFuncSetAttribute((const void*)fwd_megakernel, hipFuncAttributeMaxDynamicSharedMemorySize, LDS_BYTES) != hipSuccess) { fprintf(stderr, "kernel_launch: hipFuncSetAttribute failed\n"); grid_blocks = -1; return; }
        if (hipOccupancyMaxActiveBlocksPerMultiprocessor(&per_cu, (const void*)fwd_megakernel, 512, LDS_BYTES) != hipSuccess || per_cu < 1) { fprintf(stderr, "kernel_launch: occupancy query says %d\n", per_cu); per_cu = 1; }
        (void)hipGetLastError();
        grid_blocks = cus * per_cu;
    }
    if (grid_blocks < 0) return;
    if (hipMemsetAsync((char*)d_ws + WS_BAR, 0, 16384, stream) != hipSuccess) { fprintf(stderr, "kernel_launch: memset of the barrier words failed\n"); return; }
    Args a{};
    for (int i = 0; i < 18; ++i) a.in[i] = (const float*)d_in[i];
    a.out = (float*)d_out; a.ws = (unsigned char*)d_ws;
    void* args[] = {&a};
    hipError_t e = hipLaunchCooperativeKernel((const void*)fwd_megakernel, dim3(grid_blocks), dim3(512), args, LDS_BYTES, stream);
    if (e != hipSuccess) fprintf(stderr, "cooperative launch failed: %s (grid %d)\n", hipGetErrorString(e), grid_blocks);
}
```

```cpp
#include <hip/hip_runtime.h>
#include <hip/hip_cooperative_groups.h>
#include <cstdio>
namespace cg = cooperative_groups;

#define LAS __attribute__((address_space(3)))
#define DI __device__ __forceinline__
typedef unsigned short bf16_t;
typedef short bf16x8 __attribute__((ext_vector_type(8)));
typedef float f32x4 __attribute__((ext_vector_type(4)));
typedef float f32x2 __attribute__((ext_vector_type(2)));
typedef unsigned u32x4 __attribute__((ext_vector_type(4)));
typedef unsigned u32x2 __attribute__((ext_vector_type(2)));
typedef __bf16 bf16v2 __attribute__((ext_vector_type(2)));

constexpr int NTOK = 65536, DM = 1024, DFF = 2816, SEQ = 8192, DIN = 8208;
constexpr int LDS_BYTES = 131072 + 16;

constexpr size_t SZ_W13 = (size_t)5632 * 1024 * 2, SZ_W2T = (size_t)1024 * 2816 * 2, SZ_1K = (size_t)1024 * 1024 * 2;
constexpr size_t WS_W13_1 = 0;
constexpr size_t WS_W2T_1 = WS_W13_1 + SZ_W13;
constexpr size_t WS_W13_2 = WS_W2T_1 + SZ_W2T;
constexpr size_t WS_W2T_2 = WS_W13_2 + SZ_W13;
constexpr size_t WS_WQK = WS_W2T_2 + SZ_W2T;
constexpr size_t WS_WV = WS_WQK + 2 * SZ_1K;
constexpr size_t WS_WRG = WS_WV + 2 * SZ_1K;
constexpr size_t WS_WBR = WS_WRG + 4 * SZ_1K;
constexpr size_t WS_WBG = WS_WBR + SZ_1K;
constexpr size_t WS_WOUT = WS_WBG + SZ_1K;
constexpr size_t WS_WLR = WS_WOUT + SZ_1K;
constexpr size_t WS_ROTC = WS_WLR + 32768;
constexpr size_t WS_ROTS = WS_ROTC + (size_t)8192 * 64 * 4;
constexpr size_t WS_XN = WS_ROTS + (size_t)8192 * 64 * 4;
constexpr size_t SZ_ACT = (size_t)NTOK * 1024 * 2;
constexpr size_t WS_BIG = WS_XN + SZ_ACT;
constexpr size_t WS_G = WS_BIG;
constexpr size_t WS_QKOA = WS_BIG;
constexpr size_t WS_QKOB = WS_QKOA + SZ_ACT;
constexpr size_t WS_VTA = WS_QKOB + SZ_ACT;
constexpr size_t WS_VTB = WS_VTA + SZ_ACT;
constexpr size_t WS_GAB = WS_VTA;
constexpr size_t WS_CUM = WS_VTB + SZ_ACT;
constexpr size_t WS_MRG = WS_CUM;
constexpr size_t WS_BAR = WS_CUM + (size_t)NTOK * 512 * 4;
constexpr size_t WS_STATE = WS_BAR + 16384;
constexpr size_t WS_DSEG = WS_STATE + (size_t)64 * 3 * 32768 * 4;
constexpr size_t WS_SS1 = WS_DSEG + 64 * 3 * 128 * 4;
constexpr size_t WS_SS2 = WS_SS1 + (size_t)NTOK * 4;
constexpr size_t WS_END = WS_SS2 + (size_t)NTOK * 4;

struct Args {
    const float* in[18];
    float* out;
    unsigned char* ws;
};

DI unsigned pk_bf16(float lo, float hi) { f32x2 v = {lo, hi}; return __builtin_bit_cast(unsigned, __builtin_convertvector(v, bf16v2)); }
DI float bf_lo(unsigned w) { return __uint_as_float(w << 16); }
DI float bf_hi(unsigned w) { return __uint_as_float(w & 0xffff0000u); }
DI int opaque_tid() { int t = threadIdx.x; asm volatile("" : "+v"(t)); return t; }
DI float rowscale(const float* ss, int row) { return rsqrtf(ss[row] * (1.0f / 1024.0f) + 1e-6f); }
struct RowScales { float r[2][4]; };
DI RowScales load_rowscales(const float* ss, int row0) {
    RowScales t;
#pragma unroll
    for (int ai = 0; ai < 2; ++ai)
#pragma unroll
        for (int m = 0; m < 4; ++m) t.r[ai][m] = ss[row0 + ai * 128 + m * 16];
#pragma unroll
    for (int ai = 0; ai < 2; ++ai)
#pragma unroll
        for (int m = 0; m < 4; ++m) t.r[ai][m] = rsqrtf(t.r[ai][m] * (1.0f / 1024.0f) + 1e-6f);
    return t;
}
DI float h_get(u32x4 w, int j) { return (float)__builtin_bit_cast(_Float16, (unsigned short)(w[j >> 1] >> (16 * (j & 1)))); }
DI f32x4 bf_lo4(u32x4 w) { f32x4 r; r[0] = bf_lo(w.x); r[1] = bf_hi(w.x); r[2] = bf_lo(w.y); r[3] = bf_hi(w.y); return r; }
DI f32x4 bf_hi4(u32x4 w) { f32x4 r; r[0] = bf_lo(w.z); r[1] = bf_hi(w.z); r[2] = bf_lo(w.w); r[3] = bf_hi(w.w); return r; }
DI float fast_sigmoid(float x) { return __builtin_amdgcn_rcpf(1.0f + __expf(-x)); }
DI float fast_silu(float x) { return x * fast_sigmoid(x); }

namespace pg8 {
constexpr int BM = 256, BK = 64, HALF = 128, HTB = HALF * BK * 2, STAGE_BYTES = 8 * HTB, NXCD = 8, WGM = 8;
DI int lds_byte(int r, int c) { const int st = (r >> 4) * 2 + (c >> 5), rr = r & 15, cc = c & 31, ob = rr * 64 + cc * 2; return st * 1024 + (ob ^ (((ob >> 9) & 1) << 5)); }
DI void stage_rc(int b, int& R, int& C) { const int st = b / 1024, sb = b % 1024, swz = sb ^ (((sb >> 9) & 1) << 5); R = (st >> 1) * 16 + swz / 64; C = (st & 1) * 32 + (swz % 64) / 2; }
DI int perm32(int rho) { const int n = rho >> 4, i = rho & 15; return 8 * (i >> 2) + 4 * n + (i & 3); }
struct Unit { int pm, pn; };
struct Gemm { const bf16_t* A; const bf16_t* Bt; int M, N, K; };
struct StaticOrder {
    int nM, nN, nwg, G, c;
    DI void init(int M, int N, int G_, int c_) { nM = M / BM; nN = N / BM; nwg = nM * nN; G = G_; c = c_; }
    DI bool next(int i, Unit& u) const {
        const long L = (long)i * G + c; if (L >= nwg) return false;
        int wgid = (int)L; { const int q = nwg / NXCD, r = nwg % NXCD, xcd = wgid % NXCD, off = wgid / NXCD; wgid = (xcd < r ? xcd * (q + 1) : r * (q + 1) + (xcd - r) * q) + off; }
        const int nig = WGM * nN, gid = wgid / nig, fm = gid * WGM, gsz = (nM - fm) < WGM ? (nM - fm) : WGM;
        u.pm = fm + ((wgid % nig) % gsz); u.pn = (wgid % nig) / gsz; return true;
    }
};

template <class Epi>
DI void gemm_phase(LAS unsigned char* lds, const Gemm g, const StaticOrder S, const Epi E) {
    const int tid = opaque_tid(), wid = __builtin_amdgcn_readfirstlane(tid >> 6), lane = tid & 63, wr = wid >> 2, wc = wid & 3, fr = lane & 15, fq = lane >> 4;
    const int K = g.K, nt = K / BK;
    unsigned voffA[2], voffB[2];
#pragma unroll
    for (int i = 0; i < 2; ++i) { int R, C; stage_rc(tid * 16 + i * 8192, R, C); const int Rb = (R & ~31) + perm32(R & 31);
        voffA[i] = (unsigned)(R * K + C) * 2u; voffB[i] = (unsigned)(Rb * K + C) * 2u; }
    const size_t kstep = (size_t)(BK * 2);
    const size_t hstep = (size_t)HALF * K * 2;
    const size_t tstep = 2 * hstep;
    const unsigned ldsw = (unsigned)wid * 1024u;
    const int aoff = lds_byte(wr * 64 + fr, fq * 8), boff = lds_byte(wc * 32 + fr, fq * 8);
#define PG8_SA(b, h) (((b) * 2 + (h)) * HTB)
#define PG8_SB(b, h) ((4 + (b) * 2 + (h)) * HTB)
#define PG8_STAGE(bufoff, gbase, voff) do { _Pragma("unroll") for (int _i = 0; _i < 2; ++_i) \
        __builtin_amdgcn_global_load_lds((const unsigned*)((const char*)(gbase) + (voff)[_i]), (LAS unsigned*)(lds + (bufoff) + ldsw + _i * 8192), 16, 0, 0); } while (0)
#define PG8_LDA(dst, b, h) do { _Pragma("unroll") for (int m = 0; m < 4; ++m) _Pragma("unroll") for (int k = 0; k < 2; ++k) dst[m][k] = *(const LAS bf16x8*)(lds + PG8_SA(b, h) + aoff + m * 2048 + k * 1024); } while (0)
#define PG8_LDB(dst, b, h) do { _Pragma("unroll") for (int n = 0; n < 2; ++n) _Pragma("unroll") for (int k = 0; k < 2; ++k) dst[n][k] = *(const LAS bf16x8*)(lds + PG8_SB(b, h) + boff + n * 2048 + k * 1024); } while (0)
#define PG8_MMA(ai, bj, At, Bt) do { __builtin_amdgcn_s_setprio(1); _Pragma("unroll") for (int m = 0; m < 4; ++m) _Pragma("unroll") for (int n = 0; n < 2; ++n) _Pragma("unroll") for (int k = 0; k < 2; ++k) \
        acc[ai][bj][m][n] = __builtin_amdgcn_mfma_f32_16x16x32_bf16(Bt[n][k], At[m][k], acc[ai][bj][m][n], 0, 0, 0); __builtin_amdgcn_s_setprio(0); } while (0)
#define PG8_WAIT_V(n) asm volatile("s_waitcnt vmcnt(" #n ")" ::: "memory")
#define PG8_WAIT_L(n) asm volatile("s_waitcnt lgkmcnt(" #n ")" ::: "memory")
#define PG8_BAR __builtin_amdgcn_s_barrier()
#define PG8_SCHED __builtin_amdgcn_sched_barrier(0)
    Unit cur, nxt; int ui = 0;
    if (!S.next(0, cur)) return;
    f32x4 acc[2][2][4][2];
#pragma unroll
    for (int a = 0; a < 2; ++a)
#pragma unroll
        for (int b = 0; b < 2; ++b)
#pragma unroll
            for (int m = 0; m < 4; ++m)
#pragma unroll
                for (int n = 0; n < 2; ++n) acc[a][b][m][n] = (f32x4){0.f, 0.f, 0.f, 0.f};
    bf16x8 At[4][2], B0[2][2], B1[2][2];
    const char* cA = (const char*)g.A + (size_t)cur.pm * tstep; const char* cB = (const char*)g.Bt + (size_t)cur.pn * tstep;
    PG8_STAGE(PG8_SB(0, 0), cB, voffB); PG8_STAGE(PG8_SA(0, 0), cA, voffA); PG8_STAGE(PG8_SB(0, 1), cB + hstep, voffB); PG8_STAGE(PG8_SA(0, 1), cA + hstep, voffA);
    if (wr == 1) PG8_BAR;
    PG8_WAIT_V(4); PG8_BAR;
    PG8_STAGE(PG8_SB(1, 0), cB + kstep, voffB); PG8_STAGE(PG8_SA(1, 0), cA + kstep, voffA); PG8_STAGE(PG8_SB(1, 1), cB + hstep + kstep, voffB);
    PG8_WAIT_V(6); PG8_BAR;
    for (;;) {
        const bool has_next = S.next(ui + 1, nxt);
        const char* nA = has_next ? (const char*)g.A + (size_t)nxt.pm * tstep : cA; const char* nB = has_next ? (const char*)g.Bt + (size_t)nxt.pn * tstep : cB;
        for (int t = 0; t < nt; t += 2) {
            const bool last = (t == nt - 2);
            const char* a1 = cA + (size_t)(t + 1) * kstep;
            const char* a2 = last ? nA : cA + (size_t)(t + 2) * kstep; const char* b2 = last ? nB : cB + (size_t)(t + 2) * kstep;
            const char* a3 = a2 + kstep; const char* b3 = b2 + kstep;
            PG8_LDB(B0, 0, 0); PG8_SCHED; PG8_LDA(At, 0, 0); PG8_STAGE(PG8_SA(1, 1), a1 + hstep, voffA);
            PG8_WAIT_L(8); PG8_BAR; PG8_WAIT_L(0); PG8_MMA(0, 0, At, B0); PG8_BAR; PG8_SCHED;
            PG8_LDB(B1, 0, 1); PG8_STAGE(PG8_SB(0, 0), b2, voffB);
            PG8_BAR; PG8_WAIT_L(0); PG8_MMA(0, 1, At, B1); PG8_BAR;
            PG8_LDA(At, 0, 1); PG8_STAGE(PG8_SA(0, 0), a2, voffA);
            PG8_BAR; PG8_WAIT_L(0); PG8_MMA(1, 0, At, B0); PG8_BAR; PG8_SCHED;
            PG8_STAGE(PG8_SB(0, 1), b2 + hstep, voffB);
            PG8_WAIT_V(6); PG8_BAR; PG8_MMA(1, 1, At, B1); PG8_BAR;
            PG8_LDB(B0, 1, 0); PG8_SCHED; PG8_LDA(At, 1, 0); PG8_STAGE(PG8_SA(0, 1), a2 + hstep, voffA);
            PG8_WAIT_L(8); PG8_BAR; PG8_WAIT_L(0); PG8_MMA(0, 0, At, B0); PG8_BAR; PG8_SCHED;
            PG8_LDB(B1, 1, 1); PG8_STAGE(PG8_SB(1, 0), b3, voffB);
            PG8_BAR; PG8_WAIT_L(0); PG8_MMA(0, 1, At, B1); PG8_BAR;
            PG8_LDA(At, 1, 1); PG8_STAGE(PG8_SA(1, 0), a3, voffA);
            PG8_BAR; PG8_WAIT_L(0); PG8_MMA(1, 0, At, B0); PG8_BAR; PG8_SCHED;
            PG8_STAGE(PG8_SB(1, 1), b3 + hstep, voffB);
            PG8_WAIT_V(6); PG8_BAR; PG8_MMA(1, 1, At, B1); PG8_BAR;
        }
        E(acc, cur, wr, wc, fr, fq);
        if (!has_next) break;
#pragma unroll
        for (int a = 0; a < 2; ++a)
#pragma unroll
            for (int b = 0; b < 2; ++b)
#pragma unroll
                for (int m = 0; m < 4; ++m)
#pragma unroll
                    for (int n = 0; n < 2; ++n) acc[a][b][m][n] = (f32x4){0.f, 0.f, 0.f, 0.f};
        cur = nxt; cA = nA; cB = nB; ++ui;
    }
    PG8_WAIT_V(0);
    if (wr == 0) PG8_BAR;
    PG8_BAR;
#undef PG8_SA
#undef PG8_SB
#undef PG8_STAGE
#undef PG8_LDA
#undef PG8_LDB
#undef PG8_MMA
#undef PG8_WAIT_V
#undef PG8_WAIT_L
#undef PG8_BAR
#undef PG8_SCHED
}
template <class Epi0, class Epi1>
DI void gemm_phase_dual(LAS unsigned char* lds, const Gemm g, const Gemm g1, const StaticOrder S, const StaticOrder S1, const Epi0 E0, const Epi1 E1) {
    const int tid = opaque_tid(), wid = __builtin_amdgcn_readfirstlane(tid >> 6), lane = tid & 63, wr = wid >> 2, wc = wid & 3, fr = lane & 15, fq = lane >> 4;
    const int K = g.K, nt = K / BK;
    unsigned voffA[2], voffB[2];
#pragma unroll
    for (int i = 0; i < 2; ++i) { int R, C; stage_rc(tid * 16 + i * 8192, R, C); const int Rb = (R & ~31) + perm32(R & 31);
        voffA[i] = (unsigned)(R * K + C) * 2u; voffB[i] = (unsigned)(Rb * K + C) * 2u; }
    const size_t kstep = (size_t)(BK * 2);
    const size_t hstep = (size_t)HALF * K * 2;
    const size_t tstep = 2 * hstep;
    const unsigned ldsw = (unsigned)wid * 1024u;
    const int aoff = lds_byte(wr * 64 + fr, fq * 8), boff = lds_byte(wc * 32 + fr, fq * 8);
#define PG8_SA(b, h) (((b) * 2 + (h)) * HTB)
#define PG8_SB(b, h) ((4 + (b) * 2 + (h)) * HTB)
#define PG8_STAGE(bufoff, gbase, voff) do { _Pragma("unroll") for (int _i = 0; _i < 2; ++_i) \
        __builtin_amdgcn_global_load_lds((const unsigned*)((const char*)(gbase) + (voff)[_i]), (LAS unsigned*)(lds + (bufoff) + ldsw + _i * 8192), 16, 0, 0); } while (0)
#define PG8_LDA(dst, b, h) do { _Pragma("unroll") for (int m = 0; m < 4; ++m) _Pragma("unroll") for (int k = 0; k < 2; ++k) dst[m][k] = *(const LAS bf16x8*)(lds + PG8_SA(b, h) + aoff + m * 2048 + k * 1024); } while (0)
#define PG8_LDB(dst, b, h) do { _Pragma("unroll") for (int n = 0; n < 2; ++n) _Pragma("unroll") for (int k = 0; k < 2; ++k) dst[n][k] = *(const LAS bf16x8*)(lds + PG8_SB(b, h) + boff + n * 2048 + k * 1024); } while (0)
#define PG8_MMA(ai, bj, At, Bt) do { __builtin_amdgcn_s_setprio(1); _Pragma("unroll") for (int m = 0; m < 4; ++m) _Pragma("unroll") for (int n = 0; n < 2; ++n) _Pragma("unroll") for (int k = 0; k < 2; ++k) \
        acc[ai][bj][m][n] = __builtin_amdgcn_mfma_f32_16x16x32_bf16(Bt[n][k], At[m][k], acc[ai][bj][m][n], 0, 0, 0); __builtin_amdgcn_s_setprio(0); } while (0)
#define PG8_WAIT_V(n) asm volatile("s_waitcnt vmcnt(" #n ")" ::: "memory")
#define PG8_WAIT_L(n) asm volatile("s_waitcnt lgkmcnt(" #n ")" ::: "memory")
#define PG8_BAR __builtin_amdgcn_s_barrier()
#define PG8_SCHED __builtin_amdgcn_sched_barrier(0)
    Unit cur, nxt; int ui = 0;
    if (!S.next(0, cur)) return;
    f32x4 acc[2][2][4][2];
#pragma unroll
    for (int a = 0; a < 2; ++a)
#pragma unroll
        for (int b = 0; b < 2; ++b)
#pragma unroll
            for (int m = 0; m < 4; ++m)
#pragma unroll
                for (int n = 0; n < 2; ++n) acc[a][b][m][n] = (f32x4){0.f, 0.f, 0.f, 0.f};
    bf16x8 At[4][2], B0[2][2], B1[2][2];
    const char* cA = (const char*)g.A + (size_t)cur.pm * tstep; const char* cB = (const char*)g.Bt + (size_t)cur.pn * tstep;
    PG8_STAGE(PG8_SB(0, 0), cB, voffB); PG8_STAGE(PG8_SA(0, 0), cA, voffA); PG8_STAGE(PG8_SB(0, 1), cB + hstep, voffB); PG8_STAGE(PG8_SA(0, 1), cA + hstep, voffA);
    if (wr == 1) PG8_BAR;
    PG8_WAIT_V(4); PG8_BAR;
    PG8_STAGE(PG8_SB(1, 0), cB + kstep, voffB); PG8_STAGE(PG8_SA(1, 0), cA + kstep, voffA); PG8_STAGE(PG8_SB(1, 1), cB + hstep + kstep, voffB);
    PG8_WAIT_V(6); PG8_BAR;
    for (;;) {
        const int nj = (ui + 1) & 1;
        const bool has_next = nj ? S1.next((ui + 1) >> 1, nxt) : S.next((ui + 1) >> 1, nxt);
        const char* nAb = nj ? (const char*)g1.A : (const char*)g.A; const char* nBb = nj ? (const char*)g1.Bt : (const char*)g.Bt;
        const char* nA = has_next ? nAb + (size_t)nxt.pm * tstep : cA; const char* nB = has_next ? nBb + (size_t)nxt.pn * tstep : cB;
        for (int t = 0; t < nt; t += 2) {
            const bool last = (t == nt - 2);
            const char* a1 = cA + (size_t)(t + 1) * kstep;
            const char* a2 = last ? nA : cA + (size_t)(t + 2) * kstep; const char* b2 = last ? nB : cB + (size_t)(t + 2) * kstep;
            const char* a3 = a2 + kstep; const char* b3 = b2 + kstep;
            PG8_LDB(B0, 0, 0); PG8_SCHED; PG8_LDA(At, 0, 0); PG8_STAGE(PG8_SA(1, 1), a1 + hstep, voffA);
            PG8_WAIT_L(8); PG8_BAR; PG8_WAIT_L(0); PG8_MMA(0, 0, At, B0); PG8_BAR; PG8_SCHED;
            PG8_LDB(B1, 0, 1); PG8_STAGE(PG8_SB(0, 0), b2, voffB);
            PG8_BAR; PG8_WAIT_L(0); PG8_MMA(0, 1, At, B1); PG8_BAR;
            PG8_LDA(At, 0, 1); PG8_STAGE(PG8_SA(0, 0), a2, voffA);
            PG8_BAR; PG8_WAIT_L(0); PG8_MMA(1, 0, At, B0); PG8_BAR; PG8_SCHED;
            PG8_STAGE(PG8_SB(0, 1), b2 + hstep, voffB);
            PG8_WAIT_V(6); PG8_BAR; PG8_MMA(1, 1, At, B1); PG8_BAR;
            PG8_LDB(B0, 1, 0); PG8_SCHED; PG8_LDA(At, 1, 0); PG8_STAGE(PG8_SA(0, 1), a2 + hstep, voffA);
            PG8_WAIT_L(8); PG8_BAR; PG8_WAIT_L(0); PG8_MMA(0, 0, At, B0); PG8_BAR; PG8_SCHED;
            PG8_LDB(B1, 1, 1); PG8_STAGE(PG8_SB(1, 0), b3, voffB);
            PG8_BAR; PG8_WAIT_L(0); PG8_MMA(0, 1, At, B1); PG8_BAR;
            PG8_LDA(At, 1, 1); PG8_STAGE(PG8_SA(1, 0), a3, voffA);
            PG8_BAR; PG8_WAIT_L(0); PG8_MMA(1, 0, At, B0); PG8_BAR; PG8_SCHED;
            PG8_STAGE(PG8_SB(1, 1), b3 + hstep, voffB);
            PG8_WAIT_V(6); PG8_BAR; PG8_MMA(1, 1, At, B1); PG8_BAR;
        }
        if (ui & 1) E1(acc, cur, wr, wc, fr, fq); else E0(acc, cur, wr, wc, fr, fq);
        if (!has_next) break;
#pragma unroll
        for (int a = 0; a < 2; ++a)
#pragma unroll
            for (int b = 0; b < 2; ++b)
#pragma unroll
                for (int m = 0; m < 4; ++m)
#pragma unroll
                    for (int n = 0; n < 2; ++n) acc[a][b][m][n] = (f32x4){0.f, 0.f, 0.f, 0.f};
        cur = nxt; cA = nA; cB = nB; ++ui;
    }
    PG8_WAIT_V(0);
    if (wr == 0) PG8_BAR;
    PG8_BAR;
#undef PG8_SA
#undef PG8_SB
#undef PG8_STAGE
#undef PG8_LDA
#undef PG8_LDB
#undef PG8_MMA
#undef PG8_WAIT_V
#undef PG8_WAIT_L
#undef PG8_BAR
#undef PG8_SCHED
}
}
using pg8::Unit;
typedef const f32x4 (&AccRef)[2][2][4][2];

template <bool RS> struct EpiSwiGLU {
    bf16_t* G; const float* ss;
    DI void operator()(AccRef acc, const Unit& u, int wr, int wc, int fr, int fq) const {
        const int row0 = u.pm * 256 + wr * 64 + fr, col = u.pn * 128 + wc * 32 + 8 * fq;
        RowScales rsc; if (RS) rsc = load_rowscales(ss, row0);
#pragma unroll
        for (int ai = 0; ai < 2; ++ai)
#pragma unroll
            for (int m = 0; m < 4; ++m) {
                const int row = row0 + ai * 128 + m * 16;
                const float r = RS ? rsc.r[ai][m] : 1.0f;
                const f32x4 a0 = acc[ai][0][m][0] * r, a1 = acc[ai][0][m][1] * r, b0 = acc[ai][1][m][0] * r, b1 = acc[ai][1][m][1] * r;
                u32x4 w;
                w.x = pk_bf16(fast_silu(a0[0]) * b0[0], fast_silu(a0[1]) * b0[1]); w.y = pk_bf16(fast_silu(a0[2]) * b0[2], fast_silu(a0[3]) * b0[3]);
                w.z = pk_bf16(fast_silu(a1[0]) * b1[0], fast_silu(a1[1]) * b1[1]); w.w = pk_bf16(fast_silu(a1[2]) * b1[2], fast_silu(a1[3]) * b1[3]);
                *(u32x4*)(G + (size_t)row * DFF + col) = w;
            }
    }
};
template <bool STATS, bool HALFSTEP> struct EpiRes {
    const float* base; float* out; bf16_t* xnb; float* ss;
    DI void operator()(AccRef acc, const Unit& u, int wr, int wc, int fr, int fq) const {
        const float scale = HALFSTEP ? 0.5f : 1.0f;
        const int row0 = u.pm * 256 + wr * 64 + fr, col0 = u.pn * 256 + wc * 32 + 8 * fq;
#pragma unroll
        for (int ai = 0; ai < 2; ++ai) {
            f32x4 bv[4][2][2];
#pragma unroll
            for (int m = 0; m < 4; ++m)
#pragma unroll
                for (int bj = 0; bj < 2; ++bj) {
                    const size_t o = (size_t)(row0 + ai * 128 + m * 16) * DM + col0 + bj * 128;
                    bv[m][bj][0] = *(const f32x4*)(base + o); bv[m][bj][1] = *(const f32x4*)(base + o + 4);
                }
#pragma unroll
            for (int m = 0; m < 4; ++m) {
                const int row = row0 + ai * 128 + m * 16;
                float q = 0.f;
#pragma unroll
                for (int bj = 0; bj < 2; ++bj) {
                    const size_t o = (size_t)row * DM + col0 + bj * 128;
                    const f32x4 r0 = bv[m][bj][0] + scale * acc[ai][bj][m][0], r1 = bv[m][bj][1] + scale * acc[ai][bj][m][1];
                    *(f32x4*)(out + o) = r0;
                    *(f32x4*)(out + o + 4) = r1;
                    if (STATS) {
                        u32x4 w; w.x = pk_bf16(r0[0], r0[1]); w.y = pk_bf16(r0[2], r0[3]); w.z = pk_bf16(r1[0], r1[1]); w.w = pk_bf16(r1[2], r1[3]);
                        *(u32x4*)(xnb + o) = w;
                        q += r0[0] * r0[0] + r0[1] * r0[1] + r0[2] * r0[2] + r0[3] * r0[3] + r1[0] * r1[0] + r1[1] * r1[1] + r1[2] * r1[2] + r1[3] * r1[3];
                    }
                }
                if (STATS) { q += __shfl_xor(q, 16); q += __shfl_xor(q, 32); if (fq == 0) atomicAdd(ss + row, q); }
            }
        }
    }
};
template <bool STATS, bool HALFSTEP, bool BASEF32> struct EpiRes16 {
    const float* basef; bf16_t* xnb; float* ss;
    DI void operator()(AccRef acc, const Unit& u, int wr, int wc, int fr, int fq) const {
        const float scale = HALFSTEP ? 0.5f : 1.0f;
        const int row0 = u.pm * 256 + wr * 64 + fr, col0 = u.pn * 256 + wc * 32 + 8 * fq;
#pragma unroll
        for (int ai = 0; ai < 2; ++ai) {
            f32x4 bv[4][2][2];
#pragma unroll
            for (int m = 0; m < 4; ++m)
#pragma unroll
                for (int bj = 0; bj < 2; ++bj) {
                    const size_t o = (size_t)(row0 + ai * 128 + m * 16) * DM + col0 + bj * 128;
                    if (BASEF32) { bv[m][bj][0] = *(const f32x4*)(basef + o); bv[m][bj][1] = *(const f32x4*)(basef + o + 4); }
                    else { const u32x4 h = *(const u32x4*)(xnb + o); bv[m][bj][0] = bf_lo4(h); bv[m][bj][1] = bf_hi4(h); }
                }
#pragma unroll
            for (int m = 0; m < 4; ++m) {
                const int row = row0 + ai * 128 + m * 16;
                float q = 0.f;
#pragma unroll
                for (int bj = 0; bj < 2; ++bj) {
                    const size_t o = (size_t)row * DM + col0 + bj * 128;
                    const f32x4 r0 = bv[m][bj][0] + scale * acc[ai][bj][m][0], r1 = bv[m][bj][1] + scale * acc[ai][bj][m][1];
                    u32x4 w; w.x = pk_bf16(r0[0], r0[1]); w.y = pk_bf16(r0[2], r0[3]); w.z = pk_bf16(r1[0], r1[1]); w.w = pk_bf16(r1[2], r1[3]);
                    *(u32x4*)(xnb + o) = w;
                    if (STATS) q += r0[0] * r0[0] + r0[1] * r0[1] + r0[2] * r0[2] + r0[3] * r0[3] + r1[0] * r1[0] + r1[1] * r1[1] + r1[2] * r1[2] + r1[3] * r1[3];
                }
                if (STATS) { q += __shfl_xor(q, 16); q += __shfl_xor(q, 32); if (fq == 0) atomicAdd(ss + row, q); }
            }
        }
    }
};
struct EpiResFinal {
    static constexpr int NST = 16;
    const float* base; bf16_t* out16;
    DI void operator()(AccRef acc, const Unit& u, int wr, int wc, int fr, int fq) const {
        const int row0 = u.pm * 256 + wr * 64 + fr, col0 = u.pn * 256 + wc * 32 + 8 * fq;
#pragma unroll
        for (int ai = 0; ai < 2; ++ai) {
            f32x4 bv[4][2][2];
#pragma unroll
            for (int m = 0; m < 4; ++m)
#pragma unroll
                for (int bj = 0; bj < 2; ++bj) {
                    const size_t o = (size_t)(row0 + ai * 128 + m * 16) * DM + col0 + bj * 128;
                    bv[m][bj][0] = *(const f32x4*)(base + o); bv[m][bj][1] = *(const f32x4*)(base + o + 4);
                }
#pragma unroll
            for (int m = 0; m < 4; ++m)
#pragma unroll
                for (int bj = 0; bj < 2; ++bj) {
                    const size_t o = (size_t)(row0 + ai * 128 + m * 16) * DM + col0 + bj * 128;
                    const f32x4 r0 = bv[m][bj][0] + 0.5f * acc[ai][bj][m][0], r1 = bv[m][bj][1] + 0.5f * acc[ai][bj][m][1];
                    u32x4 w; w.x = pk_bf16(r0[0], r0[1]); w.y = pk_bf16(r0[2], r0[3]); w.z = pk_bf16(r1[0], r1[1]); w.w = pk_bf16(r1[2], r1[3]);
                    *(u32x4*)(out16 + o) = w;
                }
        }
    }
};
struct EpiQK {
    bf16_t* qkoA; bf16_t* qkoB; const float* cosT; const float* sinT; const float* ss;
    DI void operator()(AccRef acc, const Unit& u, int wr, int wc, int fr, int fq) const {
        const int X = u.pn >> 2, h = u.pn & 3, isk = wc >> 1, i0 = (wc & 1) * 32 + 8 * fq;
        bf16_t* dst = (X ? qkoB : qkoA) + h * 256 + isk * 128 + i0;
        const float qs0 = isk ? 1.0f : 0.08838834764831845f;
        const int row0 = u.pm * 256 + wr * 64 + fr;
        const RowScales rsc = load_rowscales(ss, row0);
#pragma unroll
        for (int ai = 0; ai < 2; ++ai) {
            f32x4 cs[4][2], sn[4][2];
            if (X == 0) {
#pragma unroll
                for (int m = 0; m < 4; ++m) {
                    const int pos = (row0 + ai * 128 + m * 16) & (SEQ - 1);
                    cs[m][0] = *(const f32x4*)(cosT + pos * 64 + i0); cs[m][1] = *(const f32x4*)(cosT + pos * 64 + i0 + 4);
                    sn[m][0] = *(const f32x4*)(sinT + pos * 64 + i0); sn[m][1] = *(const f32x4*)(sinT + pos * 64 + i0 + 4);
                }
            } else {
#pragma unroll
                for (int m = 0; m < 4; ++m) { cs[m][0] = cs[m][1] = (f32x4){1.f, 1.f, 1.f, 1.f}; sn[m][0] = sn[m][1] = (f32x4){0.f, 0.f, 0.f, 0.f}; }
            }
#pragma unroll
            for (int m = 0; m < 4; ++m) {
                const int row = row0 + ai * 128 + m * 16;
                const float qs = qs0 * rsc.r[ai][m];
                const f32x4 x1 = acc[ai][0][m][0], x2 = acc[ai][1][m][0], y1 = acc[ai][0][m][1], y2 = acc[ai][1][m][1];
                f32x4 a1, a2, b1, b2;
                if (X == 0) {
                    a1 = (x1 * cs[m][0] - x2 * sn[m][0]) * qs; a2 = (x2 * cs[m][0] + x1 * sn[m][0]) * qs;
                    b1 = (y1 * cs[m][1] - y2 * sn[m][1]) * qs; b2 = (y2 * cs[m][1] + y1 * sn[m][1]) * qs;
                } else { a1 = x1 * qs; a2 = x2 * qs; b1 = y1 * qs; b2 = y2 * qs; }
                u32x4 w1, w2;
                w1.x = pk_bf16(a1[0], a1[1]); w1.y = pk_bf16(a1[2], a1[3]); w1.z = pk_bf16(b1[0], b1[1]); w1.w = pk_bf16(b1[2], b1[3]);
                w2.x = pk_bf16(a2[0], a2[1]); w2.y = pk_bf16(a2[2], a2[3]); w2.z = pk_bf16(b2[0], b2[1]); w2.w = pk_bf16(b2[2], b2[3]);
                *(u32x4*)(dst + (size_t)row * 1024) = w1;
                *(u32x4*)(dst + (size_t)row * 1024 + 64) = w2;
            }
        }
    }
};
struct EpiVT {
    bf16_t* vtA; bf16_t* vtB; const float* ss;
    DI void operator()(AccRef acc, const Unit& u, int wr, int wc, int fr, int fq) const {
        f32x4 ts[2][2];
#pragma unroll
        for (int bj = 0; bj < 2; ++bj) { const int tok = u.pn * 256 + bj * 128 + wc * 32 + 8 * fq; ts[bj][0] = *(const f32x4*)(ss + tok); ts[bj][1] = *(const f32x4*)(ss + tok + 4); }
#pragma unroll
        for (int bj = 0; bj < 2; ++bj)
#pragma unroll
            for (int n = 0; n < 2; ++n)
#pragma unroll
                for (int e = 0; e < 4; ++e) ts[bj][n][e] = rsqrtf(ts[bj][n][e] * (1.0f / 1024.0f) + 1e-6f);
#pragma unroll
        for (int ai = 0; ai < 2; ++ai)
#pragma unroll
            for (int m = 0; m < 4; ++m) {
                const int R = u.pm * 256 + ai * 128 + wr * 64 + m * 16 + fr, X = R >> 10, hv = R & 1023;
#pragma unroll
                for (int bj = 0; bj < 2; ++bj) {
                    const int tok = u.pn * 256 + bj * 128 + wc * 32 + 8 * fq, b = tok >> 13, s = tok & (SEQ - 1);
                    bf16_t* dst = (X ? vtB : vtA) + ((size_t)(((b * 4 + (hv >> 8)) * 128 + (s >> 6)) * 256 + (hv & 255))) * 64 + (s & 63);
                    const f32x4 v0 = acc[ai][bj][m][0] * ts[bj][0], v1 = acc[ai][bj][m][1] * ts[bj][1];
                    u32x4 w; w.x = pk_bf16(v0[0], v0[1]); w.y = pk_bf16(v0[2], v0[3]); w.z = pk_bf16(v1[0], v1[1]); w.w = pk_bf16(v1[2], v1[3]);
                    *(u32x4*)dst = w;
                }
            }
    }
};
struct EpiRGate {
    bf16_t* oA; bf16_t* oB; const float* ss;
    DI void operator()(AccRef acc, const Unit& u, int wr, int wc, int fr, int fq) const {
        const int row0 = u.pm * 256 + wr * 64 + fr;
        bf16_t* O = (u.pn < 4 ? oA : oB) + (u.pn & 3) * 256 + wc * 32 + 8 * fq;
        const RowScales rsc = load_rowscales(ss, row0);
#pragma unroll
        for (int ai = 0; ai < 2; ++ai) {
            u32x4 ov[4][2];
#pragma unroll
            for (int m = 0; m < 4; ++m)
#pragma unroll
                for (int bj = 0; bj < 2; ++bj) ov[m][bj] = *(const u32x4*)(O + (size_t)(row0 + ai * 128 + m * 16) * 1024 + bj * 128);
#pragma unroll
            for (int m = 0; m < 4; ++m)
#pragma unroll
                for (int bj = 0; bj < 2; ++bj) {
                    bf16_t* p = O + (size_t)(row0 + ai * 128 + m * 16) * 1024 + bj * 128;
                    const float rs = rsc.r[ai][m];
                    const u32x4 o = ov[m][bj]; const f32x4 r0 = acc[ai][bj][m][0] * rs, r1 = acc[ai][bj][m][1] * rs;
                    u32x4 w;
                    w.x = pk_bf16(fast_silu(r0[0]) * bf_lo(o.x), fast_silu(r0[1]) * bf_hi(o.x)); w.y = pk_bf16(fast_silu(r0[2]) * bf_lo(o.y), fast_silu(r0[3]) * bf_hi(o.y));
                    w.z = pk_bf16(fast_silu(r1[0]) * bf_lo(o.z), fast_silu(r1[1]) * bf_hi(o.z)); w.w = pk_bf16(fast_silu(r1[2]) * bf_lo(o.w), fast_silu(r1[3]) * bf_hi(o.w));
                    *(u32x4*)p = w;
                }
        }
    }
};
struct EpiGates {
    bf16_t* gab; const float* ss;
    DI void operator()(AccRef acc, const Unit& u, int wr, int wc, int fr, int fq) const {
        const int row0 = u.pm * 256 + wr * 64 + fr;
        bf16_t* Gp = gab + (size_t)(u.pm * 8 + u.pn) * 65536 + (wr * 64 + fr) * 256 + wc * 32 + 8 * fq;
        const RowScales rsc = load_rowscales(ss, row0);
#pragma unroll
        for (int ai = 0; ai < 2; ++ai)
#pragma unroll
            for (int m = 0; m < 4; ++m)
#pragma unroll
                for (int bj = 0; bj < 2; ++bj) {
                    const float rs = rsc.r[ai][m];
                    const f32x4 r0 = acc[ai][bj][m][0] * rs, r1 = acc[ai][bj][m][1] * rs;
                    u32x4 w;
                    w.x = pk_bf16(fast_sigmoid(r0[0]), fast_sigmoid(r0[1])); w.y = pk_bf16(fast_sigmoid(r0[2]), fast_sigmoid(r0[3]));
                    w.z = pk_bf16(fast_sigmoid(r1[0]), fast_sigmoid(r1[1])); w.w = pk_bf16(fast_sigmoid(r1[2]), fast_sigmoid(r1[3]));
                    *(u32x4*)(Gp + (ai * 128 + m * 16) * 256 + bj * 128) = w;
                }
    }
};
template <int SECOND> struct EpiMerge {
    const bf16_t* gab; bf16_t* mrg;
    DI void operator()(AccRef acc, const Unit& u, int wr, int wc, int fr, int fq) const {
        const int row0 = u.pm * 256 + wr * 64 + fr, col0 = u.pn * 256 + wc * 32 + 8 * fq;
#pragma unroll
        for (int ai = 0; ai < 2; ++ai)
#pragma unroll
            for (int mh = 0; mh < 2; ++mh) {
                u32x4 gv[2][2], mv[2][2];
#pragma unroll
                for (int mm = 0; mm < 2; ++mm)
#pragma unroll
                    for (int bj = 0; bj < 2; ++bj) {
                        const size_t row = (size_t)(row0 + ai * 128 + (mh * 2 + mm) * 16); const int col = col0 + bj * 128;
                        gv[mm][bj] = *(const u32x4*)(gab + (size_t)(u.pm * 8 + SECOND * 4 + u.pn) * 65536 + (wr * 64 + fr + ai * 128 + (mh * 2 + mm) * 16) * 256 + wc * 32 + 8 * fq + bj * 128);
                        if (SECOND) mv[mm][bj] = *(const u32x4*)(mrg + row * 1024 + col);
                    }
#pragma unroll
                for (int mm = 0; mm < 2; ++mm)
#pragma unroll
                    for (int bj = 0; bj < 2; ++bj) {
                        const int m = mh * 2 + mm;
                        const size_t row = (size_t)(row0 + ai * 128 + m * 16); const int col = col0 + bj * 128;
                        const u32x4 gt = gv[mm][bj];
                        const f32x4 r0 = acc[ai][bj][m][0], r1 = acc[ai][bj][m][1];
                        float v[8] = {bf_lo(gt.x) * r0[0], bf_hi(gt.x) * r0[1], bf_lo(gt.y) * r0[2], bf_hi(gt.y) * r0[3], bf_lo(gt.z) * r1[0], bf_hi(gt.z) * r1[1], bf_lo(gt.w) * r1[2], bf_hi(gt.w) * r1[3]};
                        if (SECOND) { const u32x4 o = mv[mm][bj]; v[0] += bf_lo(o.x); v[1] += bf_hi(o.x); v[2] += bf_lo(o.y); v[3] += bf_hi(o.y); v[4] += bf_lo(o.z); v[5] += bf_hi(o.z); v[6] += bf_lo(o.w); v[7] += bf_hi(o.w); }
                        u32x4 w; w.x = pk_bf16(v[0], v[1]); w.y = pk_bf16(v[2], v[3]); w.z = pk_bf16(v[4], v[5]); w.w = pk_bf16(v[6], v[7]);
                        *(u32x4*)(mrg + row * 1024 + col) = w;
                    }
            }
    }
};

template <class Epi> DI void run_gemm(LAS unsigned char* lds, const bf16_t* A, const bf16_t* Bt, int M, int N, int K, const Epi E) {
    pg8::Gemm g; g.A = A; g.Bt = Bt; g.M = M; g.N = N; g.K = K;
    pg8::StaticOrder S; S.init(M, N, (int)gridDim.x, (int)blockIdx.x);
    pg8::gemm_phase<Epi>(lds, g, S, E);
}

template <class Epi0, class Epi1> DI void run_gemm_dual(LAS unsigned char* lds, const bf16_t* A0, const bf16_t* Bt0, const bf16_t* A1, const bf16_t* Bt1, int M, int N, int K, const Epi0 E0, const Epi1 E1) {
    pg8::Gemm g0; g0.A = A0; g0.Bt = Bt0; g0.M = M; g0.N = N; g0.K = K;
    pg8::Gemm g1 = g0; g1.A = A1; g1.Bt = Bt1;
    pg8::StaticOrder S; S.init(M, N, (int)gridDim.x, (int)blockIdx.x);
    pg8::gemm_phase_dual<Epi0, Epi1>(lds, g0, g1, S, S, E0, E1);
}
template <class Epi0, class Epi1> DI void run_gemm_dual2(LAS unsigned char* lds, const bf16_t* A0, const bf16_t* Bt0, int M0, int N0, const bf16_t* A1, const bf16_t* Bt1, int M1, int N1, int K, const Epi0 E0, const Epi1 E1) {
    pg8::Gemm g0; g0.A = A0; g0.Bt = Bt0; g0.M = M0; g0.N = N0; g0.K = K;
    pg8::Gemm g1; g1.A = A1; g1.Bt = Bt1; g1.M = M1; g1.N = N1; g1.K = K;
    pg8::StaticOrder S0; S0.init(M0, N0, (int)gridDim.x, (int)blockIdx.x);
    pg8::StaticOrder S1; S1.init(M1, N1, (int)gridDim.x, (int)blockIdx.x);
    pg8::gemm_phase_dual<Epi0, Epi1>(lds, g0, g1, S0, S1, E0, E1);
}

DI void wprep_tile(LAS unsigned char* lds, const float* src, int col0, int ldw, int K, bf16_t* dst, int r0, int k0, const float* ksc) {
    const int t = opaque_tid(), c = t & 63, kk = t >> 6;
    float v[8];
#pragma unroll
    for (int i = 0; i < 8; ++i) v[i] = src[(size_t)(k0 + kk * 8 + i) * ldw + col0 + c];
    if (ksc) {
#pragma unroll
        for (int i = 0; i < 8; ++i) v[i] *= ksc[k0 + kk * 8 + i];
    }
    u32x4 w; w.x = pk_bf16(v[0], v[1]); w.y = pk_bf16(v[2], v[3]); w.z = pk_bf16(v[4], v[5]); w.w = pk_bf16(v[6], v[7]);
    *(LAS u32x4*)(lds + c * 144 + kk * 16) = w;
    __syncthreads();
    const int row = t >> 3, seg = t & 7;
    const u32x4 o = *(const LAS u32x4*)(lds + row * 144 + seg * 16);
    *(u32x4*)(dst + (size_t)(r0 + row) * K + k0 + seg * 8) = o;
    __syncthreads();
}
DI void wprep_tile4(LAS unsigned char* lds, const float* src, int col0, int ldw, int K, bf16_t* dst, int r0, int k0, const float* ksc) {
    const int t = opaque_tid(), c = t & 63, kk = t >> 6;
    float v[4][8];
#pragma unroll
    for (int q = 0; q < 4; ++q)
#pragma unroll
        for (int i = 0; i < 8; ++i) v[q][i] = src[(size_t)(k0 + q * 64 + kk * 8 + i) * ldw + col0 + c];
    if (ksc) {
#pragma unroll
        for (int q = 0; q < 4; ++q)
#pragma unroll
            for (int i = 0; i < 8; ++i) v[q][i] *= ksc[k0 + q * 64 + kk * 8 + i];
    }
#pragma unroll
    for (int q = 0; q < 4; ++q) {
        u32x4 w; w.x = pk_bf16(v[q][0], v[q][1]); w.y = pk_bf16(v[q][2], v[q][3]); w.z = pk_bf16(v[q][4], v[q][5]); w.w = pk_bf16(v[q][6], v[q][7]);
        *(LAS u32x4*)(lds + q * 9216 + c * 144 + kk * 16) = w;
    }
    __syncthreads();
    const int row = t >> 3, seg = t & 7;
#pragma unroll
    for (int q = 0; q < 4; ++q) {
        const u32x4 o = *(const LAS u32x4*)(lds + q * 9216 + row * 144 + seg * 16);
        *(u32x4*)(dst + (size_t)(r0 + row) * K + k0 + q * 64 + seg * 8) = o;
    }
    __syncthreads();
}
template <class F> DI void wjob(LAS unsigned char* lds, int& off, const int G, const int c, int nrb, int nkb, int K, int ldw, bf16_t* dst, const float* src, const float* ksc, F&& mapf) {
    const int nkb4 = nkb >> 2, ntl = nrb * nkb4;
    const int start = ((c - off) % G + G) % G;
    for (int t = start; t < ntl; t += G) { const int rb = t / nkb4, kb = t % nkb4; int col0, drow; mapf(rb, col0, drow); wprep_tile4(lds, src, col0, ldw, K, dst, drow, kb * 256, ksc); }
    off += ntl;
}
template <int PART> DI void wprep_jobs(const Args& a, LAS unsigned char* lds, const int G, const int c) {
    unsigned char* ws = a.ws;
    const float* win = a.in[6];
    int off = 0;
    auto mapW1 = [](int rb, int& col0, int& drow) { col0 = rb * 64; drow = (rb >> 1) * 256 + (rb & 1) * 64; };
    auto mapW3 = [](int rb, int& col0, int& drow) { col0 = rb * 64; drow = (rb >> 1) * 256 + 128 + (rb & 1) * 64; };
    auto mapId = [](int rb, int& col0, int& drow) { col0 = rb * 64; drow = rb * 64; };
    if (PART == 0) {
        wjob(lds, off, G, c, 44, 16, 1024, DFF, (bf16_t*)(ws + WS_W13_1), a.in[2], nullptr, mapW1);
        wjob(lds, off, G, c, 44, 16, 1024, DFF, (bf16_t*)(ws + WS_W13_1), a.in[3], nullptr, mapW3);
        wjob(lds, off, G, c, 16, 44, DFF, 1024, (bf16_t*)(ws + WS_W2T_1), a.in[4], nullptr, mapId);
        wjob(lds, off, G, c, 32, 16, 1024, DIN, (bf16_t*)(ws + WS_WQK), win, a.in[5], [](int rb, int& col0, int& drow) { const int r0 = rb * 64, tile = r0 >> 8, X = tile >> 2, h = tile & 3, seg = (r0 & 255) >> 6;
            col0 = (X ? 3072 : 0) + ((seg & 1) ? 512 : 0) + h * 128 + (seg >> 1) * 64; drow = r0; });
        wjob(lds, off, G, c, 32, 16, 1024, DIN, (bf16_t*)(ws + WS_WV), win, a.in[5], [](int rb, int& col0, int& drow) { const int r0 = rb * 64; col0 = (r0 < 1024) ? 1024 + r0 : 4096 + (r0 - 1024); drow = r0; });
    } else {
        wjob(lds, off, G, c, 64, 16, 1024, DIN, (bf16_t*)(ws + WS_WRG), win, a.in[5], [](int rb, int& col0, int& drow) { const int r0 = rb * 64, q = r0 >> 10, r = r0 & 1023; col0 = (q == 0 ? 2048 : q == 1 ? 5120 : q == 2 ? 6160 : 7184) + r; drow = r0; });
        wjob(lds, off, G, c, 16, 16, 1024, 1024, (bf16_t*)(ws + WS_WBR), a.in[10], nullptr, mapId);
        wjob(lds, off, G, c, 16, 16, 1024, 1024, (bf16_t*)(ws + WS_WBG), a.in[11], nullptr, mapId);
        wjob(lds, off, G, c, 16, 16, 1024, 1024, (bf16_t*)(ws + WS_WOUT), a.in[12], nullptr, mapId);
        wjob(lds, off, G, c, 44, 16, 1024, DFF, (bf16_t*)(ws + WS_W13_2), a.in[14], a.in[13], mapW1);
        wjob(lds, off, G, c, 44, 16, 1024, DFF, (bf16_t*)(ws + WS_W13_2), a.in[15], a.in[13], mapW3);
        wjob(lds, off, G, c, 16, 44, DFF, 1024, (bf16_t*)(ws + WS_W2T_2), a.in[16], nullptr, mapId);
    }
}
DI void wprep_phase(const Args& a, LAS unsigned char* lds) {
    unsigned char* ws = a.ws;
    const float* win = a.in[6];
    wprep_jobs<0>(a, lds, (int)gridDim.x, (int)blockIdx.x);
    {
        bf16_t* wlr = (bf16_t*)(ws + WS_WLR);
        for (int i = blockIdx.x * 512 + threadIdx.x; i < 16 * 1024; i += gridDim.x * 512) { const int r = i >> 10, k = i & 1023; wlr[i] = (bf16_t)(pk_bf16(win[(size_t)k * DIN + 6144 + r] * a.in[5][k], 0.f) & 0xffffu); }
    }
    { float* z = (float*)(ws + WS_SS1); for (int i = blockIdx.x * 512 + threadIdx.x; i < 2 * NTOK; i += gridDim.x * 512) z[i] = 0.f; }
    {
        float* ct = (float*)(ws + WS_ROTC); float* st = (float*)(ws + WS_ROTS);
        for (int i = blockIdx.x * 512 + threadIdx.x; i < SEQ * 64; i += gridDim.x * 512) {
            const int pos = i >> 6, f = i & 63;
            double inv = 1.0, cb = 0.8659643233600653;
#pragma unroll
            for (int bit = 0; bit < 6; ++bit) { if ((f >> bit) & 1) inv *= cb; cb *= cb; }
            const double rev = (double)pos * inv * 0.15915494309189535;
            const float r = (float)(rev - rint(rev));
            ct[i] = __builtin_amdgcn_cosf(r); st[i] = __builtin_amdgcn_sinf(r);
        }
    }
}

template <bool OUT_BF16> DI void rmsnorm_phase(const float* src, const float* w, void* dstv) {
    const int tid_ = opaque_tid(), lane = tid_ & 63, wid = tid_ >> 6;
    f32x4 wv[4];
#pragma unroll
    for (int j = 0; j < 4; ++j) wv[j] = *(const f32x4*)(w + j * 256 + lane * 4);
    for (int row = (blockIdx.x * 8 + wid) * 2; row < NTOK; row += gridDim.x * 16) {
        f32x4 v[2][4]; float ss[2] = {0.f, 0.f};
#pragma unroll
        for (int r = 0; r < 2; ++r)
#pragma unroll
            for (int j = 0; j < 4; ++j) v[r][j] = *(const f32x4*)(src + (size_t)(row + r) * DM + j * 256 + lane * 4);
#pragma unroll
        for (int r = 0; r < 2; ++r)
#pragma unroll
            for (int j = 0; j < 4; ++j) ss[r] += v[r][j][0] * v[r][j][0] + v[r][j][1] * v[r][j][1] + v[r][j][2] * v[r][j][2] + v[r][j][3] * v[r][j][3];
#pragma unroll
        for (int o = 32; o >= 1; o >>= 1) { ss[0] += __shfl_xor(ss[0], o); ss[1] += __shfl_xor(ss[1], o); }
#pragma unroll
        for (int r = 0; r < 2; ++r) {
            const float rs = rsqrtf(ss[r] * (1.0f / 1024.0f) + 1e-6f);
#pragma unroll
            for (int j = 0; j < 4; ++j) {
                const f32x4 y = v[r][j] * rs * wv[j];
                if (OUT_BF16) { u32x2 o; o.x = pk_bf16(y[0], y[1]); o.y = pk_bf16(y[2], y[3]); *(u32x2*)((bf16_t*)dstv + (size_t)(row + r) * DM + j * 256 + lane * 4) = o; }
                else *(f32x4*)((float*)dstv + (size_t)(row + r) * DM + j * 256 + lane * 4) = y;
            }
        }
    }
}

DI void final_norm_phase(const bf16_t* src, const float* w, float* dst) {
    const int tid_ = opaque_tid(), lane = tid_ & 63, wid = tid_ >> 6;
    f32x4 wv[2][2];
#pragma unroll
    for (int j = 0; j < 2; ++j) { wv[j][0] = *(const f32x4*)(w + j * 512 + lane * 8); wv[j][1] = *(const f32x4*)(w + j * 512 + lane * 8 + 4); }
    for (int row = (blockIdx.x * 8 + wid) * 2; row < NTOK; row += gridDim.x * 16) {
        u32x4 hv[2][2];
#pragma unroll
        for (int r = 0; r < 2; ++r)
#pragma unroll
            for (int j = 0; j < 2; ++j) hv[r][j] = *(const u32x4*)(src + (size_t)(row + r) * DM + j * 512 + lane * 8);
        float ss[2] = {0.f, 0.f};
        f32x4 v[2][2][2];
#pragma unroll
        for (int r = 0; r < 2; ++r)
#pragma unroll
            for (int j = 0; j < 2; ++j) {
                v[r][j][0] = bf_lo4(hv[r][j]); v[r][j][1] = bf_hi4(hv[r][j]);
#pragma unroll
                for (int e = 0; e < 4; ++e) ss[r] += v[r][j][0][e] * v[r][j][0][e] + v[r][j][1][e] * v[r][j][1][e];
            }
#pragma unroll
        for (int o = 32; o >= 1; o >>= 1) { ss[0] += __shfl_xor(ss[0], o); ss[1] += __shfl_xor(ss[1], o); }
#pragma unroll
        for (int r = 0; r < 2; ++r) {
            const float rs = rsqrtf(ss[r] * (1.0f / 1024.0f) + 1e-6f);
#pragma unroll
            for (int j = 0; j < 2; ++j) {
                *(f32x4*)(dst + (size_t)(row + r) * DM + j * 512 + lane * 8) = v[r][j][0] * rs * wv[j][0];
                *(f32x4*)(dst + (size_t)(row + r) * DM + j * 512 + lane * 8 + 4) = v[r][j][1] * rs * wv[j][1];
            }
        }
    }
}

DI void cum_phase(const Args& a, LAS unsigned char* lds) {
    const bf16_t* xn = (const bf16_t*)(a.ws + WS_XN); const bf16_t* wlr = (const bf16_t*)(a.ws + WS_WLR); _Float16* cumo = (_Float16*)(a.ws + WS_CUM);
    const int tid = opaque_tid(), lane = tid & 63, wid = tid >> 6, fr = lane & 15, g = lane >> 4;
    LAS float* lrp = (LAS float*)lds;
    const float* ss1 = (const float*)(a.ws + WS_SS1);
    float w2c[16];
#pragma unroll
    for (int r = 0; r < 16; ++r) w2c[r] = a.in[7][r * 512 + tid];
    const float bias = a.in[8][tid];
    for (int chunk = blockIdx.x; chunk < NTOK / 64; chunk += gridDim.x) {
        const int tok0 = chunk * 64, tt = wid & 3, kh = wid >> 2;
        f32x4 acc = {0.f, 0.f, 0.f, 0.f};
        const bf16_t* ap = xn + (size_t)(tok0 + tt * 16 + fr) * 1024 + kh * 512 + 8 * g;
        const bf16_t* bp = wlr + fr * 1024 + kh * 512 + 8 * g;
#pragma unroll
        for (int s = 0; s < 16; ++s) {
            const bf16x8 av = *(const bf16x8*)(ap + s * 32), bv = *(const bf16x8*)(bp + s * 32);
            acc = __builtin_amdgcn_mfma_f32_16x16x32_bf16(av, bv, acc, 0, 0, 0);
        }
#pragma unroll
        for (int i = 0; i < 4; ++i) lrp[(kh * 64 + tt * 16 + 4 * g + i) * 16 + fr] = acc[i] * rowscale(ss1, tok0 + tt * 16 + 4 * g + i);
        __syncthreads();
        { const float s0 = lrp[tid] + lrp[1024 + tid], s1 = lrp[512 + tid] + lrp[1536 + tid]; __syncthreads(); lrp[tid] = s0; lrp[512 + tid] = s1; }
        __syncthreads();
        float cum = 0.f;
        for (int t0 = 0; t0 < 64; t0 += 8) {
            float ls[8];
#pragma unroll
            for (int uu = 0; uu < 8; ++uu) {
                float z = bias;
#pragma unroll
                for (int q = 0; q < 4; ++q) {
                    const f32x4 l0 = *(const LAS f32x4*)(lrp + (t0 + uu) * 16 + q * 4);
#pragma unroll
                    for (int e = 0; e < 4; ++e) z += l0[e] * w2c[q * 4 + e];
                }
                ls[uu] = (fminf(z, 0.f) - __logf(1.0f + __expf(-fabsf(z)))) * (1.0f / 16.0f);
            }
#pragma unroll
            for (int uu = 0; uu < 8; ++uu) {
                cum += ls[uu];
                cumo[(size_t)(tok0 + t0 + uu) * 512 + tid] = (_Float16)(cum * 1.4426950408889634f);
            }
        }
        __syncthreads();
    }
}

constexpr int SC_QP = 0, SC_QM = 17408, SC_KP = 34816, SC_KM = 52224, SC_KT = 69632, SC_SC = 88064, SC_ST = 97280, SC_EL = 101376;
constexpr int SC_KT2 = 0, SC_EL2 = 36864;
constexpr int NSEG = 4, SEGC = 32;
DI float ret_logg(int h) { return (h == 0) ? -0.0317486983145803f : (h == 1) ? -0.015748356968139168f : (h == 2) ? -0.007843177461025893f : -0.003913899321136329f; }

DI void scan_pass1(const Args& a, LAS unsigned char* lds) {
    const int tid = opaque_tid(), lane = tid & 63, w = __builtin_amdgcn_readfirstlane(tid >> 6), fr = lane & 15, g = lane >> 4;
    const int mp = tid >> 4, dseg = tid & 15, m0 = 2 * mp, d0 = 8 * dseg;
    for (int item = blockIdx.x; item < 64 * (NSEG - 1); item += gridDim.x) {
        const int chain = item & 63, seg = item >> 6, X = chain >> 5, b = (chain >> 2) & 7, h = chain & 3;
        const bf16_t* qko = (const bf16_t*)(a.ws + (X ? WS_QKOB : WS_QKOA)) + (size_t)b * SEQ * 1024 + h * 256;
        const bf16_t* vt = (const bf16_t*)(a.ws + (X ? WS_VTB : WS_VTA)) + (size_t)((b * 4 + h) * 256) * SEQ;
        const _Float16* cumg = (const _Float16*)(a.ws + WS_CUM) + (size_t)b * SEQ * 512 + h * 128;
        const float logg = ret_logg(h);
        f32x4 S[8][2];
#pragma unroll
        for (int i = 0; i < 8; ++i) { S[i][0] = (f32x4){0.f, 0.f, 0.f, 0.f}; S[i][1] = (f32x4){0.f, 0.f, 0.f, 0.f}; }
        float dsum[8];
#pragma unroll
        for (int j = 0; j < 8; ++j) dsum[j] = 0.f;
        u32x4 pk0, pk1; u32x4 pc[2], pl; bf16x8 vf[2][2];
        auto load_chunk = [&](int ch) {
            const bf16_t* r0 = qko + (size_t)(ch * 64 + m0) * 1024 + d0 + 128;
            pk0 = *(const u32x4*)r0; pk1 = *(const u32x4*)(r0 + 1024);
            if (X) {
                const _Float16* c0 = cumg + (size_t)(ch * 64 + m0) * 512 + d0;
                pc[0] = *(const u32x4*)c0; pc[1] = *(const u32x4*)(c0 + 512);
                pl = *(const u32x4*)(cumg + (size_t)(ch * 64 + 63) * 512 + d0);
            }
        };
        auto load_vt = [&](int ch) {
#pragma unroll
            for (int vtile = 0; vtile < 2; ++vtile)
#pragma unroll
                for (int ks = 0; ks < 2; ++ks) vf[vtile][ks] = *(const bf16x8*)(vt + ((size_t)ch * 256 + 32 * w + 8 * (fr >> 2) + 4 * vtile + (fr & 3)) * 64 + 32 * ks + 8 * g);
        };
        const int c0 = seg * SEGC;
        load_chunk(c0); load_vt(c0);
        for (int ci = 0; ci < SEGC; ++ci) {
            const int ch = c0 + ci, kto = SC_KT2 + (ci & 1) * 18432, elo = SC_EL2 + (ci & 1) * 512;
            {
                float kt[2][8];
#pragma unroll
                for (int r = 0; r < 2; ++r) {
                    const u32x4 kw = r ? pk1 : pk0;
                    const float kv[8] = {bf_lo(kw.x), bf_hi(kw.x), bf_lo(kw.y), bf_hi(kw.y), bf_lo(kw.z), bf_hi(kw.z), bf_lo(kw.w), bf_hi(kw.w)};
                    if (X) {
#pragma unroll
                        for (int j = 0; j < 8; ++j) kt[r][j] = kv[j] * __builtin_amdgcn_exp2f(h_get(pl, j) - h_get(pc[r], j));
                    } else {
                        const float el = __expf((float)(63 - m0 - r) * logg);
#pragma unroll
                        for (int j = 0; j < 8; ++j) kt[r][j] = kv[j] * el;
                    }
                }
#pragma unroll
                for (int j = 0; j < 8; ++j) {
                    const int d = d0 + j;
                    *(LAS unsigned*)(lds + kto + d * 144 + (((m0 >> 3) ^ ((d >> 4) & 7)) * 16) + (m0 & 7) * 2) = pk_bf16(kt[0][j], kt[1][j]);
                }
                if (X) {
#pragma unroll
                    for (int j = 0; j < 8; ++j) dsum[j] += h_get(pl, j);
                }
                if (mp == 31) {
#pragma unroll
                    for (int j = 0; j < 8; ++j) { *(LAS float*)(lds + elo + (d0 + j) * 4) = X ? __builtin_amdgcn_exp2f(h_get(pl, j)) : __expf(64.0f * logg); }
                }
            }
            __syncthreads();
            load_chunk(ci + 1 < SEGC ? ch + 1 : ch);
#pragma unroll
            for (int dt = 0; dt < 8; ++dt) {
                const f32x4 el = *(const LAS f32x4*)(lds + elo + (16 * dt + 4 * g) * 4);
                S[dt][0] *= el; S[dt][1] *= el;
#pragma unroll
                for (int ks = 0; ks < 2; ++ks) {
                    const bf16x8 ak = *(const LAS bf16x8*)(lds + kto + (16 * dt + fr) * 144 + (((4 * ks + g) ^ (dt & 7)) * 16));
#pragma unroll
                    for (int vtile = 0; vtile < 2; ++vtile) S[dt][vtile] = __builtin_amdgcn_mfma_f32_16x16x32_bf16(ak, vf[vtile][ks], S[dt][vtile], 0, 0, 0);
                }
            }
            load_vt(ci + 1 < SEGC ? ch + 1 : ch);
        }
        float* st = (float*)(a.ws + WS_STATE) + (size_t)(chain * (NSEG - 1) + seg) * 32768;
#pragma unroll
        for (int dt = 0; dt < 8; ++dt)
#pragma unroll
            for (int vtile = 0; vtile < 2; ++vtile) *(f32x4*)(st + ((dt * 2 + vtile) * 512 + tid) * 4) = S[dt][vtile];
        if (mp == 0) {
            float* dg = (float*)(a.ws + WS_DSEG) + (chain * (NSEG - 1) + seg) * 128 + d0;
#pragma unroll
            for (int j = 0; j < 8; ++j) dg[j] = X ? __builtin_amdgcn_exp2f(dsum[j]) : __expf((float)(64 * SEGC) * logg);
        }
        __syncthreads();
    }
}

template <int X> DI void scan_item2(const Args& a, LAS unsigned char* lds, const int chain, const int seg) {
    const int tid = opaque_tid(), lane = tid & 63, w = __builtin_amdgcn_readfirstlane(tid >> 6), fr = lane & 15, g = lane >> 4;
    const int mp = tid >> 4, dseg = tid & 15, m0 = 2 * mp, d0 = 8 * dseg;
    {
        const int b = (chain >> 2) & 7, h = chain & 3;
        bf16_t* qko = (bf16_t*)(a.ws + (X ? WS_QKOB : WS_QKOA)) + (size_t)b * SEQ * 1024 + h * 256;
        const bf16_t* vt = (const bf16_t*)(a.ws + (X ? WS_VTB : WS_VTA)) + (size_t)((b * 4 + h) * 256) * SEQ;
        const _Float16* cumg = (const _Float16*)(a.ws + WS_CUM) + (size_t)b * SEQ * 512 + h * 128;
        const float logg = ret_logg(h);

        f32x4 S[8][2];
#pragma unroll
        for (int i = 0; i < 8; ++i) { S[i][0] = (f32x4){0.f, 0.f, 0.f, 0.f}; S[i][1] = (f32x4){0.f, 0.f, 0.f, 0.f}; }
        for (int j = 0; j < seg; ++j) {
            const float* st = (const float*)(a.ws + WS_STATE) + (size_t)(chain * (NSEG - 1) + j) * 32768;
            const float* dg = (const float*)(a.ws + WS_DSEG) + (chain * (NSEG - 1) + j) * 128;
#pragma unroll
            for (int dt = 0; dt < 8; ++dt) {
                const f32x4 dj = *(const f32x4*)(dg + 16 * dt + 4 * g);
#pragma unroll
                for (int vtile = 0; vtile < 2; ++vtile) S[dt][vtile] = S[dt][vtile] * dj + *(const f32x4*)(st + ((dt * 2 + vtile) * 512 + tid) * 4);
            }
        }

        u32x4 pq0, pq1, pk0, pk1; u32x4 pc[2], pl; bf16x8 vf[2][2];
        auto load_chunk = [&](int ch) {
            const bf16_t* r0 = qko + (size_t)(ch * 64 + m0) * 1024 + d0;
            pq0 = *(const u32x4*)r0; pk0 = *(const u32x4*)(r0 + 128); pq1 = *(const u32x4*)(r0 + 1024); pk1 = *(const u32x4*)(r0 + 1024 + 128);
            if (X) {
                const _Float16* c0 = cumg + (size_t)(ch * 64 + m0) * 512 + d0;
                pc[0] = *(const u32x4*)c0; pc[1] = *(const u32x4*)(c0 + 512);
                pl = *(const u32x4*)(cumg + (size_t)(ch * 64 + 63) * 512 + d0);
            }
        };
        auto load_vt = [&](int ch) {
#pragma unroll
            for (int vtile = 0; vtile < 2; ++vtile)
#pragma unroll
                for (int ks = 0; ks < 2; ++ks) vf[vtile][ks] = *(const bf16x8*)(vt + ((size_t)ch * 256 + 32 * w + 8 * (fr >> 2) + 4 * vtile + (fr & 3)) * 64 + 32 * ks + 8 * g);
        };
        const int cbeg = seg * SEGC, cend = cbeg + SEGC;
        load_chunk(cbeg); load_vt(cbeg);

        for (int ch = cbeg; ch < cend; ++ch) {
            {
                float kt[2][8];
                float elj[8];
                if (X) {
#pragma unroll
                    for (int j = 0; j < 8; ++j) elj[j] = __builtin_amdgcn_exp2f(h_get(pl, j));
                } else {
                    const float e = __expf(64.0f * logg);
#pragma unroll
                    for (int j = 0; j < 8; ++j) elj[j] = e;
                }
#pragma unroll
                for (int r = 0; r < 2; ++r) {
                    const u32x4 qw = r ? pq1 : pq0, kw = r ? pk1 : pk0;
                    const float qv[8] = {bf_lo(qw.x), bf_hi(qw.x), bf_lo(qw.y), bf_hi(qw.y), bf_lo(qw.z), bf_hi(qw.z), bf_lo(qw.w), bf_hi(qw.w)};
                    const float kv[8] = {bf_lo(kw.x), bf_hi(kw.x), bf_lo(kw.y), bf_hi(kw.y), bf_lo(kw.z), bf_hi(kw.z), bf_lo(kw.w), bf_hi(kw.w)};
                    float qp[8], qm[8], kp[8], km[8];
                    if (X) {
#pragma unroll
                        for (int j = 0; j < 8; ++j) {
                            const float ep = __builtin_amdgcn_exp2f(h_get(pc[r], j)), em = __builtin_amdgcn_rcpf(ep);
                            qp[j] = qv[j] * ep; qm[j] = qv[j] * em; kp[j] = kv[j] * ep; km[j] = kv[j] * em; kt[r][j] = km[j] * elj[j];
                        }
                    } else {
                        const float c = (float)(m0 + r + 1) * logg, ep = __expf(c), em = __expf(-c), el = __expf((float)(63 - m0 - r) * logg);
#pragma unroll
                        for (int j = 0; j < 8; ++j) { qp[j] = qv[j] * ep; qm[j] = qv[j] * em; kp[j] = kv[j] * ep; km[j] = kv[j] * em; kt[r][j] = kv[j] * el; }
                    }
                    const int off = (m0 + r) * 272 + dseg * 16;
                    u32x4 o;
                    o.x = pk_bf16(qp[0], qp[1]); o.y = pk_bf16(qp[2], qp[3]); o.z = pk_bf16(qp[4], qp[5]); o.w = pk_bf16(qp[6], qp[7]); *(LAS u32x4*)(lds + SC_QP + off) = o;
                    o.x = pk_bf16(qm[0], qm[1]); o.y = pk_bf16(qm[2], qm[3]); o.z = pk_bf16(qm[4], qm[5]); o.w = pk_bf16(qm[6], qm[7]); *(LAS u32x4*)(lds + SC_QM + off) = o;
                    o.x = pk_bf16(kp[0], kp[1]); o.y = pk_bf16(kp[2], kp[3]); o.z = pk_bf16(kp[4], kp[5]); o.w = pk_bf16(kp[6], kp[7]); *(LAS u32x4*)(lds + SC_KP + off) = o;
                    o.x = pk_bf16(km[0], km[1]); o.y = pk_bf16(km[2], km[3]); o.z = pk_bf16(km[4], km[5]); o.w = pk_bf16(km[6], km[7]); *(LAS u32x4*)(lds + SC_KM + off) = o;
                }
#pragma unroll
                for (int j = 0; j < 8; ++j) {
                    const int d = d0 + j;
                    *(LAS unsigned*)(lds + SC_KT + d * 144 + (((m0 >> 3) ^ ((d >> 4) & 7)) * 16) + (m0 & 7) * 2) = pk_bf16(kt[0][j], kt[1][j]);
                }
                if (mp == 31) {
#pragma unroll
                    for (int j = 0; j < 8; ++j) *(LAS float*)(lds + SC_EL + (d0 + j) * 4) = elj[j];
                }
            }
            __syncthreads();
            load_chunk(ch + 1 < cend ? ch + 1 : ch);
#pragma unroll
            for (int tt = 0; tt < 2; ++tt) {
                const int t = 2 * w + tt, mt = t >> 2, nt = t & 3;
                f32x4 t1 = {0.f, 0.f, 0.f, 0.f}, t2 = {0.f, 0.f, 0.f, 0.f};
                if (nt >= mt) {
#pragma unroll
                    for (int kk = 0; kk < 4; ++kk) {
                        const int ao = (16 * mt + fr) * 272 + (32 * kk + 8 * g) * 2, bo = (16 * nt + fr) * 272 + (32 * kk + 8 * g) * 2;
                        const bf16x8 akm = *(const LAS bf16x8*)(lds + SC_KM + ao), bqp = *(const LAS bf16x8*)(lds + SC_QP + bo);
                        t1 = __builtin_amdgcn_mfma_f32_16x16x32_bf16(akm, bqp, t1, 0, 0, 0);
                    }
                }
                if (nt <= mt) {
#pragma unroll
                    for (int kk = 0; kk < 4; ++kk) {
                        const int ao = (16 * mt + fr) * 272 + (32 * kk + 8 * g) * 2, bo = (16 * nt + fr) * 272 + (32 * kk + 8 * g) * 2;
                        const bf16x8 akp = *(const LAS bf16x8*)(lds + SC_KP + ao), bqm = *(const LAS bf16x8*)(lds + SC_QM + bo);
                        t2 = __builtin_amdgcn_mfma_f32_16x16x32_bf16(akp, bqm, t2, 0, 0, 0);
                    }
                }
                const int n = 16 * nt + fr, mb = 16 * mt + 4 * g;
                float sv[4];
#pragma unroll
                for (int i = 0; i < 4; ++i) sv[i] = (n >= mb + i) ? t1[i] : t2[i];
                u32x2 o; o.x = pk_bf16(sv[0], sv[1]); o.y = pk_bf16(sv[2], sv[3]);
                *(LAS u32x2*)(lds + SC_SC + n * 144 + mb * 2) = o;
            }
            __syncthreads();
            f32x4 oacc[2][4];
#pragma unroll
            for (int vtile = 0; vtile < 2; ++vtile)
#pragma unroll
                for (int nt = 0; nt < 4; ++nt) oacc[vtile][nt] = (f32x4){0.f, 0.f, 0.f, 0.f};
#pragma unroll
            for (int ks = 0; ks < 2; ++ks)
#pragma unroll
                for (int nt = 0; nt < 4; ++nt) {
                    const bf16x8 bs = *(const LAS bf16x8*)(lds + SC_SC + (16 * nt + fr) * 144 + ks * 64 + g * 16);
#pragma unroll
                    for (int vtile = 0; vtile < 2; ++vtile) oacc[vtile][nt] = __builtin_amdgcn_mfma_f32_16x16x32_bf16(vf[vtile][ks], bs, oacc[vtile][nt], 0, 0, 0);
                }
#pragma unroll
            for (int kk = 0; kk < 4; ++kk) {
                bf16x8 sa[2];
#pragma unroll
                for (int vtile = 0; vtile < 2; ++vtile) {
                    const f32x4 s0 = S[2 * kk][vtile], s1 = S[2 * kk + 1][vtile];
                    u32x4 p; p.x = pk_bf16(s0[0], s0[1]); p.y = pk_bf16(s0[2], s0[3]); p.z = pk_bf16(s1[0], s1[1]); p.w = pk_bf16(s1[2], s1[3]);
                    sa[vtile] = __builtin_bit_cast(bf16x8, p);
                }
#pragma unroll
                for (int nt = 0; nt < 4; ++nt) {
                    const int qo = SC_QP + (16 * nt + fr) * 272 + (32 * kk + 4 * g) * 2;
                    const u32x2 lo = *(const LAS u32x2*)(lds + qo), hi = *(const LAS u32x2*)(lds + qo + 32);
                    u32x4 p; p.x = lo.x; p.y = lo.y; p.z = hi.x; p.w = hi.y;
                    const bf16x8 bq = __builtin_bit_cast(bf16x8, p);
#pragma unroll
                    for (int vtile = 0; vtile < 2; ++vtile) oacc[vtile][nt] = __builtin_amdgcn_mfma_f32_16x16x32_bf16(sa[vtile], bq, oacc[vtile][nt], 0, 0, 0);
                }
            }
#pragma unroll
            for (int dt = 0; dt < 8; ++dt) {
                const f32x4 el = *(const LAS f32x4*)(lds + SC_EL + (16 * dt + 4 * g) * 4);
                S[dt][0] *= el; S[dt][1] *= el;
#pragma unroll
                for (int ks = 0; ks < 2; ++ks) {
                    const bf16x8 ak = *(const LAS bf16x8*)(lds + SC_KT + (16 * dt + fr) * 144 + (((4 * ks + g) ^ (dt & 7)) * 16));
#pragma unroll
                    for (int vtile = 0; vtile < 2; ++vtile) S[dt][vtile] = __builtin_amdgcn_mfma_f32_16x16x32_bf16(ak, vf[vtile][ks], S[dt][vtile], 0, 0, 0);
                }
            }
            load_vt(ch + 1 < cend ? ch + 1 : ch);
#pragma unroll
            for (int nt = 0; nt < 4; ++nt) {
                float s = 0.f, q = 0.f;
#pragma unroll
                for (int vtile = 0; vtile < 2; ++vtile)
#pragma unroll
                    for (int i = 0; i < 4; ++i) { const float x = oacc[vtile][nt][i]; s += x; q += x * x; }
                s += __shfl_xor(s, 16); q += __shfl_xor(q, 16); s += __shfl_xor(s, 32); q += __shfl_xor(q, 32);
                if (g == 0) { f32x2 sq = {s, q}; *(LAS f32x2*)(lds + SC_ST + ((16 * nt + fr) * 8 + w) * 8) = sq; }
            }
            __syncthreads();
            f32x4 nw[2];
#pragma unroll
            for (int vtile = 0; vtile < 2; ++vtile) nw[vtile] = X ? *(const f32x4*)(a.in[9] + 32 * w + 8 * g + 4 * vtile) : (f32x4){1.f, 1.f, 1.f, 1.f};
#pragma unroll
            for (int nt = 0; nt < 4; ++nt) {
                const int n = 16 * nt + fr;
                float s = 0.f, q = 0.f;
#pragma unroll
                for (int ww = 0; ww < 4; ++ww) { const f32x4 p = *(const LAS f32x4*)(lds + SC_ST + n * 64 + ww * 16); s += p[0] + p[2]; q += p[1] + p[3]; }
                float mu, rs;
                if (X) { mu = 0.f; rs = rsqrtf(q * (1.0f / 256.0f) + 1e-6f); }
                else { mu = s * (1.0f / 256.0f); const float var = fmaxf(q * (1.0f / 256.0f) - mu * mu, 0.f); rs = rsqrtf(var + 1e-6f); }
                const f32x4 y0 = (oacc[0][nt] - mu) * rs * nw[0], y1 = (oacc[1][nt] - mu) * rs * nw[1];
                u32x4 o; o.x = pk_bf16(y0[0], y0[1]); o.y = pk_bf16(y0[2], y0[3]); o.z = pk_bf16(y1[0], y1[1]); o.w = pk_bf16(y1[2], y1[3]);
                *(u32x4*)(qko + (size_t)(ch * 64 + n) * 1024 + 32 * w + 8 * g) = o;
            }
        }
        __syncthreads();
    }
}
DI void scan_pass2(const Args& a, LAS unsigned char* lds) {
    for (int item = blockIdx.x; item < 64 * NSEG; item += gridDim.x) {
        const int chain = item & 63, seg = item >> 6;
        if (chain >> 5) scan_item2<1>(a, lds, chain, seg); else scan_item2<0>(a, lds, chain, seg);
    }
}

#define XB_TMO      128
#define XB_XCNT(j)  (256  + 64 * (j))
#define XB_XSUB(j)  (1280 + 64 * (j))
#define XB_XGEN(j)  (2304 + 64 * (j))
#define XB_TOP      3328
#define XB_TOPGEN   3392
#define XCD_BAR_WORDS 3456
#define XB_SPIN_CAP (1u << 22)
DI unsigned xb_ld(unsigned* p)              { return __hip_atomic_load(p, __ATOMIC_RELAXED, __HIP_MEMORY_SCOPE_AGENT); }
DI unsigned xb_add(unsigned* p, unsigned v) { return __hip_atomic_fetch_add(p, v, __ATOMIC_RELAXED, __HIP_MEMORY_SCOPE_AGENT); }
DI unsigned xb_xcc_id() { return (unsigned)__builtin_amdgcn_s_getreg((3 << 11) | 20) & 0xFu; }
#define XB_SPIN(cond, bar) do { unsigned _sp = 0; while (cond) { __builtin_amdgcn_s_sleep(1); \
    if ((++_sp & 255u) == 0u) { if (xb_ld(&(bar)[XB_TMO])) break; if (_sp > XB_SPIN_CAP) { atomicAdd(&(bar)[XB_TMO], 1u); break; } } } } while (0)
struct XcdBarrier { unsigned* bar; unsigned x; volatile LAS unsigned* st; };
DI XcdBarrier xcd_barrier_post(unsigned* bar, volatile LAS unsigned* st) {
    XcdBarrier b; b.bar = bar; b.x = xb_xcc_id(); b.st = st;
    if (threadIdx.x == 0) (void)xb_add(&bar[XB_XCNT(b.x)], 1u);
    return b;
}
DI void xcd_barrier_complete(unsigned* bar, unsigned x, unsigned& nloc, unsigned& nx) {
    const unsigned G = gridDim.x * gridDim.y * gridDim.z;
    unsigned sum, cnt, mine, sp = 0u;
    for (;;) {
        sum = 0u; cnt = 0u; mine = 0u;
#pragma unroll
        for (unsigned j = 0; j < 16; ++j) { const unsigned c = xb_ld(&bar[XB_XCNT(j)]); sum += c; cnt += (c > 0u) ? 1u : 0u; mine = (j == x) ? c : mine; }
        if (sum == G) break;
        __builtin_amdgcn_s_sleep(1);
        if ((++sp & 255u) == 0u) { if (xb_ld(&bar[XB_TMO])) break; if (sp > XB_SPIN_CAP) { atomicAdd(&bar[XB_TMO], 1u); break; } }
    }
    nloc = mine > 0u ? mine : 1u; nx = cnt > 0u ? cnt : 1u;
}
DI void xcd_barrier(const XcdBarrier& b) {
    asm volatile("s_waitcnt vmcnt(0)" ::: "memory");
    __syncthreads();
    if (threadIdx.x == 0) {
        unsigned* bar = b.bar;
        __builtin_amdgcn_s_waitcnt(0);
        unsigned nloc = b.st[0], nx = b.st[1];
        if (nloc == 0u) { xcd_barrier_complete(bar, b.x, nloc, nx); b.st[0] = nloc; b.st[1] = nx; }
        const unsigned old = xb_add(&bar[XB_XSUB(b.x)], 1u);
        const unsigned gen = old / nloc;
        if (old + 1u == (gen + 1u) * nloc) {
            __builtin_amdgcn_fence(__ATOMIC_RELEASE, "agent");
            asm volatile("s_waitcnt vmcnt(0)" ::: "memory");
            const unsigned og = xb_add(&bar[XB_TOP], 1u);
            const unsigned tg = og / nx;
            if (og + 1u == (tg + 1u) * nx) xb_add(&bar[XB_TOPGEN], 1u);
            else XB_SPIN(xb_ld(&bar[XB_TOPGEN]) == tg, bar);
            __builtin_amdgcn_fence(__ATOMIC_ACQUIRE, "agent");
            xb_add(&bar[XB_XGEN(b.x)], 1u);
            asm volatile("s_waitcnt vmcnt(0)" ::: "memory");
        } else {
            XB_SPIN(xb_ld(&bar[XB_XGEN(b.x)]) == gen, bar);
            __builtin_amdgcn_fence(__ATOMIC_ACQUIRE, "agent");
            asm volatile("s_waitcnt vmcnt(0)" ::: "memory");
        }
    }
    __syncthreads();
}

__global__ void __launch_bounds__(512, 2) fwd_megakernel(Args a) {
    extern __shared__ __attribute__((aligned(16))) unsigned char shm[];
    LAS unsigned char* lds = (LAS unsigned char*)shm;
    cg::grid_group grid = cg::this_grid();
    unsigned char* ws = a.ws;
    bf16_t* XN = (bf16_t*)(ws + WS_XN);
    bf16_t* G = (bf16_t*)(ws + WS_G);
    bf16_t* QKOA = (bf16_t*)(ws + WS_QKOA); bf16_t* QKOB = (bf16_t*)(ws + WS_QKOB);
    bf16_t* GAB = (bf16_t*)(ws + WS_GAB); bf16_t* MRG = (bf16_t*)(ws + WS_MRG);
    float* SS1 = (float*)(ws + WS_SS1); float* SS2 = (float*)(ws + WS_SS2);

    if (threadIdx.x < 4) ((volatile LAS unsigned*)(lds + 131072))[threadIdx.x] = 0u;
    __syncthreads();
    const XcdBarrier xb = xcd_barrier_post((unsigned*)(ws + WS_BAR), (volatile LAS unsigned*)(lds + 131072));
    wprep_phase(a, lds);
    rmsnorm_phase<true>(a.in[0], a.in[1], XN);
    if (a.ws == nullptr) grid.sync();
    xcd_barrier(xb);
    { EpiSwiGLU<false> e; e.G = G; e.ss = nullptr; run_gemm(lds, XN, (const bf16_t*)(ws + WS_W13_1), NTOK, 5632, 1024, e); }
    xcd_barrier(xb);
    { EpiRes16<true, true, true> e; e.basef = a.in[0]; e.xnb = XN; e.ss = SS1; run_gemm(lds, G, (const bf16_t*)(ws + WS_W2T_1), NTOK, 1024, DFF, e); }
    xcd_barrier(xb);
    { EpiQK e0; e0.qkoA = QKOA; e0.qkoB = QKOB; e0.cosT = (const float*)(ws + WS_ROTC); e0.sinT = (const float*)(ws + WS_ROTS); e0.ss = SS1;
      EpiVT e1; e1.vtA = (bf16_t*)(ws + WS_VTA); e1.vtB = (bf16_t*)(ws + WS_VTB); e1.ss = SS1;
      run_gemm_dual2(lds, XN, (const bf16_t*)(ws + WS_WQK), NTOK, 2048, (const bf16_t*)(ws + WS_WV), XN, 2048, NTOK, 1024, e0, e1); }
    cum_phase(a, lds);
    xcd_barrier(xb);
    scan_pass1(a, lds);
    {
        const int nit = 64 * (NSEG - 1), G = (int)gridDim.x;
        if (G > nit) { if ((int)blockIdx.x >= nit) wprep_jobs<1>(a, lds, G - nit, (int)blockIdx.x - nit); }
        else wprep_jobs<1>(a, lds, G, (int)blockIdx.x);
    }
    xcd_barrier(xb);
    scan_pass2(a, lds);
    xcd_barrier(xb);
    { EpiRGate e0; e0.oA = QKOA; e0.oB = QKOB; e0.ss = SS1; EpiGates e1; e1.gab = GAB; e1.ss = SS1;
      run_gemm_dual(lds, XN, (const bf16_t*)(ws + WS_WRG), XN, (const bf16_t*)(ws + WS_WRG + 4 * SZ_1K / 2), NTOK, 2048, 1024, e0, e1); }
    xcd_barrier(xb);
    { EpiMerge<0> e0; e0.gab = GAB; e0.mrg = MRG; EpiMerge<1> e1; e1.gab = GAB; e1.mrg = MRG;
      run_gemm_dual(lds, QKOA, (const bf16_t*)(ws + WS_WBR), QKOB, (const bf16_t*)(ws + WS_WBG), NTOK, 1024, 1024, e0, e1); }
    xcd_barrier(xb);
    { EpiRes16<true, false, false> e; e.basef = nullptr; e.xnb = XN; e.ss = SS2; run_gemm(lds, MRG, (const bf16_t*)(ws + WS_WOUT), NTOK, 1024, 1024, e); }
    xcd_barrier(xb);
    { EpiSwiGLU<true> e; e.G = G; e.ss = SS2; run_gemm(lds, XN, (const bf16_t*)(ws + WS_W13_2), NTOK, 5632, 1024, e); }
    xcd_barrier(xb);
    { EpiRes16<false, true, false> e; e.basef = nullptr; e.xnb = XN; e.ss = nullptr; run_gemm(lds, G, (const bf16_t*)(ws + WS_W2T_2), NTOK, 1024, DFF, e); }
    xcd_barrier(xb);
    final_norm_phase(XN, a.in[17], a.out);
}

extern "C" void kernel_launch(void* const* d_in, const int* in_sizes, int n_in, void* d_out, int out_size, void* d_ws, size_t ws_size, hipStream_t stream) {
    static int grid_blocks = 0;
    if (grid_blocks == 0) {
        if (n_in != 18 || ws_size < WS_END) { fprintf(stderr, "kernel_launch: unexpected n_in %d / ws_size %zu (need %zu)\n", n_in, ws_size, (size_t)WS_END); grid_blocks = -1; return; }
        int dev = 0, cus = 0, per_cu = 0;
        hipGetDevice(&dev);
        hipDeviceGetAttribute(&cus, hipDeviceAttributeMultiprocessorCount, dev);
        if (hipFuncSetAttribute((const void*)fwd_megakernel, hipFuncAttributeMaxDynamicSharedMemorySize, LDS_BYTES) != hipSuccess) { fprintf(stderr, "kernel_launch: hipFuncSetAttribute failed\n"); grid_blocks = -1; return; }
        if (hipOccupancyMaxActiveBlocksPerMultiprocessor(&per_cu, (const void*)fwd_megakernel, 512, LDS_BYTES) != hipSuccess || per_cu < 1) { fprintf(stderr, "kernel_launch: occupancy query says %d\n", per_cu); per_cu = 1; }
        (void)hipGetLastError();
        grid_blocks = cus * per_cu;
    }
    if (grid_blocks < 0) return;
    if (hipMemsetAsync((char*)d_ws + WS_BAR, 0, 16384, stream) != hipSuccess) { fprintf(stderr, "kernel_launch: memset of the barrier words failed\n"); return; }
    Args a{};
    for (int i = 0; i < 18; ++i) a.in[i] = (const float*)d_in[i];
    a.out = (float*)d_out; a.ws = (unsigned char*)d_ws;
    void* args[] = {&a};
    hipError_t e = hipLaunchCooperativeKernel((const void*)fwd_megakernel, dim3(grid_blocks), dim3(512), args, LDS_BYTES, stream);
    if (e != hipSuccess) fprintf(stderr, "cooperative launch failed: %s (grid %d)\n", hipGetErrorString(e), grid_blocks);
}
```
